# Optimizing an MI355X kernel written in HIP

```python
import math
import jax, jax.numpy as jnp
from jax import lax
import numpy as np

D_MODEL = 1024
BATCH = 4
SEQ = 8192
DEPTH = 2

NORM_EPS = 1e-6
D_FF = 2816
D_MIX = D_MODEL
MLA_HEADS = 8
MLA_NOPE_DIM = 64
MLA_ROPE_DIM = 32
MLA_V_DIM = 64
MLA_QK_DIM = MLA_NOPE_DIM + MLA_ROPE_DIM
MLA_Q_RANK = 256
MLA_KV_RANK = 128
MLA_WIDTH = MLA_HEADS * MLA_V_DIM
ROPE_THETA = 10000.0
Q_BLOCK = 128
CONV_WIDTH = D_MIX // 4
CONV_KERNEL = 31
HY_WIDTH = D_MIX - MLA_WIDTH - CONV_WIDTH
HY_ORDER = 2
HY_SHORT_KERNEL = 3
HY_EMB_DIM = 33
HY_FILTER_DIM = 64
HY_FAST_DECAY_PCT = 0.3
HY_SLOW_DECAY_PCT = 1.5
HY_DECAY_TARGET = 1e-2
HY_FILTER_OUT = HY_ORDER * 2 * HY_WIDTH
IN_MLA_Q = MLA_Q_RANK
IN_MLA_KV = MLA_KV_RANK
IN_MLA_KPE = MLA_ROPE_DIM
IN_CONV = 2 * CONV_WIDTH
IN_HY = (HY_ORDER + 1) * HY_WIDTH
OFF_Q = 0
OFF_KV = OFF_Q + IN_MLA_Q
OFF_KPE = OFF_KV + IN_MLA_KV
OFF_CONV = OFF_KPE + IN_MLA_KPE
OFF_HY = OFF_CONV + IN_CONV
IN_COLS = OFF_HY + IN_HY

kernel_name = "hymba_mla_conformer_hyena_macaron"


def rmsnorm(x, g):
    xf = x.astype(jnp.float32)
    xf = xf * lax.rsqrt(jnp.mean(xf * xf, axis=-1, keepdims=True) + NORM_EPS)
    return (xf * g.astype(jnp.float32)).astype(x.dtype)


def layernorm(x, g, b):
    xf = x.astype(jnp.float32)
    mu = jnp.mean(xf, axis=-1, keepdims=True)
    var = jnp.mean(jnp.square(xf - mu), axis=-1, keepdims=True)
    y = (xf - mu) * lax.rsqrt(var + NORM_EPS)
    return (y * g.astype(jnp.float32) + b.astype(jnp.float32)).astype(x.dtype)


def swiglu(h, w_gate, w_up, w_down):
    return (jax.nn.silu(h @ w_gate) * (h @ w_up)) @ w_down


def depthwise_conv(u, w, b):
    k, c = w.shape
    pad = k // 2
    y = lax.conv_general_dilated(u, w[:, None, :].astype(u.dtype), window_strides=(1,),
                                 padding=[(pad, pad)], dimension_numbers=('NWC', 'WIO', 'NWC'),
                                 feature_group_count=c)
    return y + b.astype(u.dtype)


def rope_cos_sin(positions, dtype):
    inv_freq = 1.0 / (ROPE_THETA ** (jnp.arange(0, MLA_ROPE_DIM, 2, dtype=jnp.float32) / MLA_ROPE_DIM))
    ang = positions.astype(jnp.float32)[..., None] * inv_freq
    return jnp.cos(ang).astype(dtype), jnp.sin(ang).astype(dtype)


def apply_rope(x, cos, sin):
    x1, x2 = jnp.split(x, 2, axis=-1)
    return jnp.concatenate([x1 * cos - x2 * sin, x1 * sin + x2 * cos], axis=-1)


def mla_mixer(h_q, h_kv, k_pe, positions, q_norm, w_qb, kv_norm, w_kvb):
    b, l, _ = h_q.shape
    cos, sin = rope_cos_sin(positions, h_q.dtype)
    q = (rmsnorm(h_q, q_norm) @ w_qb).reshape(b, l, MLA_HEADS, MLA_QK_DIM)
    q_pe = apply_rope(q[..., MLA_NOPE_DIM:], cos[:, :, None], sin[:, :, None])
    q = jnp.concatenate([q[..., :MLA_NOPE_DIM], q_pe], axis=-1) * (MLA_QK_DIM ** -0.5)
    kv = (rmsnorm(h_kv, kv_norm) @ w_kvb).reshape(b, l, MLA_HEADS, MLA_NOPE_DIM + MLA_V_DIM)
    k_pe = apply_rope(k_pe, cos, sin)
    k = jnp.concatenate([kv[..., :MLA_NOPE_DIM],
                         jnp.broadcast_to(k_pe[:, :, None], (b, l, MLA_HEADS, MLA_ROPE_DIM))], axis=-1)
    v = kv[..., MLA_NOPE_DIM:]
    n_blk = l // Q_BLOCK
    q_blocks = q.reshape(b, n_blk, Q_BLOCK, MLA_HEADS, MLA_QK_DIM).transpose(1, 0, 2, 3, 4)

    def attend(qb):
        s = jnp.einsum('bqhd,bkhd->bhqk', qb, k).astype(jnp.float32)
        p = jax.nn.softmax(s, axis=-1).astype(v.dtype)
        return jnp.einsum('bhqk,bkhd->bqhd', p, v)

    o = lax.map(attend, q_blocks)
    return o.transpose(1, 0, 2, 3, 4).reshape(b, l, MLA_WIDTH)


def conformer_conv_mixer(h_conv, dw_w, dw_b, ln_g, ln_b):
    a, g = jnp.split(h_conv, 2, axis=-1)
    u = a * jax.nn.sigmoid(g)
    u = depthwise_conv(u, dw_w, dw_b)
    return jax.nn.silu(layernorm(u, ln_g, ln_b))


def hyena_filters(l, w1, b1, w2, b2, w3, b3, w4, freq):
    f32 = jnp.float32
    t = jnp.linspace(0.0, 1.0, l, dtype=f32)[:, None]
    bands = (HY_EMB_DIM - 1) // 2
    ang = 2.0 * math.pi * jnp.arange(l, dtype=f32)[:, None] / l
    fb = jnp.linspace(1e-4, bands - 1, bands, dtype=f32)[None, :]
    z = jnp.concatenate([t, jnp.cos(fb * ang), -jnp.sin(fb * ang)], axis=-1)
    fr = freq.astype(f32)
    hdn = jnp.sin(fr * (z @ w1.astype(f32) + b1.astype(f32)))
    hdn = jnp.sin(fr * (hdn @ w2.astype(f32) + b2.astype(f32)))
    hdn = jnp.sin(fr * (hdn @ w3.astype(f32) + b3.astype(f32)))
    h = (hdn @ w4.astype(f32)).reshape(l, HY_ORDER, 2, HY_WIDTH)
    max_decay = math.log(HY_DECAY_TARGET) / HY_FAST_DECAY_PCT
    min_decay = math.log(HY_DECAY_TARGET) / HY_SLOW_DECAY_PCT
    deltas = jnp.linspace(min_decay, max_decay, HY_WIDTH, dtype=f32)
    h = h * jnp.exp(-t * jnp.abs(deltas))[:, None, None, :]
    fwd, bwd = h[:, :, 0], h[:, :, 1]
    k = jnp.concatenate([fwd, jnp.zeros_like(fwd[:1]), jnp.flip(bwd[1:], axis=0)], axis=0)
    return k / jnp.sum(jnp.abs(k), axis=0, keepdims=True)


def fft_long_conv(u, k, d):
    l = u.shape[1]
    uf = u.astype(jnp.float32)
    uk = jnp.fft.rfft(uf, n=2 * l, axis=1) * jnp.fft.rfft(k, axis=0)[None]
    y = jnp.fft.irfft(uk, n=2 * l, axis=1)[:, :l]
    return (y + uf * d.astype(jnp.float32)).astype(u.dtype)


def hyena_mixer(h_hy, short_w, short_b, w1, b1, w2, b2, w3, b3, w4, freq, bias_d):
    u = depthwise_conv(h_hy, short_w, short_b)
    v, x1, x2 = jnp.split(u, HY_ORDER + 1, axis=-1)
    k = hyena_filters(h_hy.shape[1], w1, b1, w2, b2, w3, b3, w4, freq)
    z = x1 * fft_long_conv(v, k[:, 0], bias_d[0])
    return x2 * fft_long_conv(z, k[:, 1], bias_d[1])


def setup_inputs(seed: int = 0) -> dict:
    key = jax.random.key(seed)
    ks = iter(jax.random.split(key, 64))
    f32 = jnp.float32

    def nrm(shape, scale):
        return jax.random.normal(next(ks), shape, f32) * scale

    def gain(shape):
        return 1.0 + nrm(shape, 0.05)

    dd = DEPTH
    return {
        "x": nrm((BATCH, SEQ, D_MODEL), 1.0),
        "positions": jnp.broadcast_to(jnp.arange(SEQ, dtype=jnp.int32)[None], (BATCH, SEQ)),
        "ffn1_norm": gain((dd, D_MODEL)),
        "ffn1_w_gate": nrm((dd, D_MODEL, D_FF), D_MODEL ** -0.5),
        "ffn1_w_up": nrm((dd, D_MODEL, D_FF), D_MODEL ** -0.5),
        "ffn1_w_down": nrm((dd, D_FF, D_MODEL), D_FF ** -0.5),
        "mix_norm": gain((dd, D_MODEL)),
        "w_in": nrm((dd, D_MODEL, IN_COLS), D_MODEL ** -0.5),
        "mla_q_norm": gain((dd, MLA_Q_RANK)),
        "mla_w_qb": nrm((dd, MLA_Q_RANK, MLA_HEADS * MLA_QK_DIM), MLA_Q_RANK ** -0.5),
        "mla_kv_norm": gain((dd, MLA_KV_RANK)),
        "mla_w_kvb": nrm((dd, MLA_KV_RANK, MLA_HEADS * (MLA_NOPE_DIM + MLA_V_DIM)), MLA_KV_RANK ** -0.5),
        "conv_dw_w": nrm((dd, CONV_KERNEL, CONV_WIDTH), CONV_KERNEL ** -0.5),
        "conv_dw_b": nrm((dd, CONV_WIDTH), 0.02),
        "conv_ln_g": gain((dd, CONV_WIDTH)),
        "conv_ln_b": nrm((dd, CONV_WIDTH), 0.02),
        "hy_short_w": nrm((dd, HY_SHORT_KERNEL, IN_HY), HY_SHORT_KERNEL ** -0.5),
        "hy_short_b": nrm((dd, IN_HY), 0.02),
        "hy_filt_w1": nrm((dd, HY_EMB_DIM, HY_FILTER_DIM), HY_EMB_DIM ** -0.5),
        "hy_filt_b1": nrm((dd, HY_FILTER_DIM), 0.1),
        "hy_filt_w2": nrm((dd, HY_FILTER_DIM, HY_FILTER_DIM), HY_FILTER_DIM ** -0.5),
        "hy_filt_b2": nrm((dd, HY_FILTER_DIM), 0.1),
        "hy_filt_w3": nrm((dd, HY_FILTER_DIM, HY_FILTER_DIM), HY_FILTER_DIM ** -0.5),
        "hy_filt_b3": nrm((dd, HY_FILTER_DIM), 0.1),
        "hy_filt_w4": nrm((dd, HY_FILTER_DIM, HY_FILTER_OUT), HY_FILTER_DIM ** -0.5),
        "hy_filt_freq": gain((dd, HY_FILTER_DIM)),
        "hy_bias_d": nrm((dd, HY_ORDER, HY_WIDTH), 0.5),
        "out_norm": gain((dd, D_MIX)),
        "w_out": nrm((dd, D_MIX, D_MODEL), D_MIX ** -0.5),
        "ffn2_norm": gain((dd, D_MODEL)),
        "ffn2_w_gate": nrm((dd, D_MODEL, D_FF), D_MODEL ** -0.5),
        "ffn2_w_up": nrm((dd, D_MODEL, D_FF), D_MODEL ** -0.5),
        "ffn2_w_down": nrm((dd, D_FF, D_MODEL), D_FF ** -0.5),
        "final_norm": gain((D_MODEL,)),
    }


def reference(x, positions, ffn1_norm, ffn1_w_gate, ffn1_w_up, ffn1_w_down, mix_norm, w_in,
              mla_q_norm, mla_w_qb, mla_kv_norm, mla_w_kvb, conv_dw_w, conv_dw_b, conv_ln_g, conv_ln_b,
              hy_short_w, hy_short_b, hy_filt_w1, hy_filt_b1, hy_filt_w2, hy_filt_b2, hy_filt_w3, hy_filt_b3,
              hy_filt_w4, hy_filt_freq, hy_bias_d, out_norm, w_out, ffn2_norm, ffn2_w_gate, ffn2_w_up,
              ffn2_w_down, final_norm):
    e1 = MLA_WIDTH
    e2 = MLA_WIDTH + CONV_WIDTH
    for i in range(DEPTH):
        x = x + 0.5 * swiglu(rmsnorm(x, ffn1_norm[i]), ffn1_w_gate[i], ffn1_w_up[i], ffn1_w_down[i])
        h = rmsnorm(x, mix_norm[i]) @ w_in[i]
        y_mla = mla_mixer(h[..., OFF_Q:OFF_KV], h[..., OFF_KV:OFF_KPE], h[..., OFF_KPE:OFF_CONV], positions,
                          mla_q_norm[i], mla_w_qb[i], mla_kv_norm[i], mla_w_kvb[i])
        y_conv = conformer_conv_mixer(h[..., OFF_CONV:OFF_HY], conv_dw_w[i], conv_dw_b[i],
                                      conv_ln_g[i], conv_ln_b[i])
        y_hy = hyena_mixer(h[..., OFF_HY:], hy_short_w[i], hy_short_b[i], hy_filt_w1[i], hy_filt_b1[i],
                           hy_filt_w2[i], hy_filt_b2[i], hy_filt_w3[i], hy_filt_b3[i], hy_filt_w4[i],
                           hy_filt_freq[i], hy_bias_d[i])
        g = out_norm[i]
        y = jnp.concatenate([rmsnorm(y_mla, g[:e1]), rmsnorm(y_conv, g[e1:e2]), rmsnorm(y_hy, g[e2:])], axis=-1)
        x = x + y @ w_out[i]
        x = x + 0.5 * swiglu(rmsnorm(x, ffn2_norm[i]), ffn2_w_gate[i], ffn2_w_up[i], ffn2_w_down[i])
    return rmsnorm(x, final_norm)
```

```cpp
#include <hip/hip_runtime.h>
#include <hip/hip_cooperative_groups.h>
#include <hip/hip_bf16.h>
#include <cstdio>
#include <cstdint>
namespace cg = cooperative_groups;
namespace pg8 {
#define PG8_LAS __attribute__((address_space(3)))
typedef unsigned short bf16_t;
typedef short bf16x8 __attribute__((ext_vector_type(8)));
typedef float f32x4 __attribute__((ext_vector_type(4)));
typedef unsigned u32x4 __attribute__((ext_vector_type(4)));
constexpr int BM = 256, BK = 64, HALF = 128, HTB = HALF * BK * 2  , STAGE_BYTES = 8 * HTB, NXCD = 8, WGM = 8;

__host__ __device__ __forceinline__ int lds_byte(int r, int c) { const int st = (r >> 4) * 2 + (c >> 5), rr = r & 15, cc = c & 31, ob = rr * 64 + cc * 2; return st * 1024 + (ob ^ (((ob >> 9) & 1) << 5)); }
__host__ __device__ __forceinline__ void stage_rc(int b, int& R, int& C) { const int st = b / 1024, sb = b % 1024, swz = sb ^ (((sb >> 9) & 1) << 5); R = (st >> 1) * 16 + swz / 64; C = (st & 1) * 32 + (swz % 64) / 2; }
__host__ __device__ __forceinline__ int perm32(int rho) { const int n = rho >> 4, i = rho & 15; return 8 * (i >> 2) + 4 * n + (i & 3); }

struct Unit { int pm, pn; };
struct Gemm { const bf16_t* A; const bf16_t* Bt; int M, N, K; };

struct StaticOrder {
    int nM, nN, nwg, G, c;
    __host__ __device__ void init(int M, int N, int G_, int c_) { nM = M / BM; nN = N / BM; nwg = nM * nN; G = G_; c = c_; }
    __host__ __device__ bool next(int i, Unit& u) const {
        const long L = (long)i * G + c; if (L >= nwg) return false;
        int wgid = (int)L; { const int q = nwg / NXCD, r = nwg % NXCD, xcd = wgid % NXCD, off = wgid / NXCD; wgid = (xcd < r ? xcd * (q + 1) : r * (q + 1) + (xcd - r) * q) + off; }
        const int nig = WGM * nN, gid = wgid / nig, fm = gid * WGM, gsz = (nM - fm) < WGM ? (nM - fm) : WGM;
        u.pm = fm + ((wgid % nig) % gsz); u.pn = (wgid % nig) / gsz; return true;
    }
    __device__ __forceinline__ void a_ready(const Unit&) const {}
    __device__ __forceinline__ void done(const Unit&) const {}
};

__device__ __forceinline__ unsigned cvt_pk_bf16(float lo, float hi) { unsigned r; asm volatile("v_cvt_pk_bf16_f32 %0, %1, %2" : "=v"(r) : "v"(lo), "v"(hi)); return r; }
typedef float f32x2 __attribute__((ext_vector_type(2)));
__device__ __forceinline__ float silu_f(float g) { return g * __builtin_amdgcn_rcpf(1.0f + __expf(-g)); }
__device__ __forceinline__ float row_rstd(const float* rss, int row) { if (!rss) return 1.0f; const f32x4 s = *(const f32x4*)(rss + 4 * (size_t)row); return __builtin_amdgcn_rsqf(((s[0] + s[1]) + (s[2] + s[3])) * (1.0f / 1024.0f) + 1e-6f); }
struct EpiBf16 {
    static constexpr bool PERM = true, AFTER_DRAIN = false;
    bf16_t* O; int ldc; const float* rss;
    __device__ __forceinline__ void operator()(const f32x4 (&acc)[2][2][4][2], const Unit& u, int wr, int wc, int fr, int fq) const {
        const int row0 = u.pm * BM + wr * 64 + fr; const int col0 = u.pn * BM + wc * 32 + 8 * fq;
#pragma unroll
        for (int ai = 0; ai < 2; ++ai)
#pragma unroll
            for (int m = 0; m < 4; ++m) { const int row = row0 + ai * HALF + m * 16; bf16_t* rowp = O + (size_t)row * ldc + col0; const float rs = row_rstd(rss, row);
#pragma unroll
                for (int bj = 0; bj < 2; ++bj) { const f32x4 v0 = acc[ai][bj][m][0] * rs, v1 = acc[ai][bj][m][1] * rs;
                    u32x4 w; w.x = cvt_pk_bf16(v0[0], v0[1]); w.y = cvt_pk_bf16(v0[2], v0[3]); w.z = cvt_pk_bf16(v1[0], v1[1]); w.w = cvt_pk_bf16(v1[2], v1[3]);
                    *(u32x4*)(rowp + bj * HALF) = w; } }
    }
};
struct EpiSwiGLU {
    static constexpr bool PERM = true, AFTER_DRAIN = false;
    bf16_t* O; int ldc; const float* rss;
    __device__ __forceinline__ void operator()(const f32x4 (&acc)[2][2][4][2], const Unit& u, int wr, int wc, int fr, int fq) const {
        const int row0 = u.pm * BM + wr * 64 + fr; const int col0 = u.pn * HALF + wc * 32 + 8 * fq;
#pragma unroll
        for (int ai = 0; ai < 2; ++ai)
#pragma unroll
            for (int m = 0; m < 4; ++m) { const int row = row0 + ai * HALF + m * 16; bf16_t* rowp = O + (size_t)row * ldc + col0; const float rs = row_rstd(rss, row);
                const f32x4 g0 = acc[ai][0][m][0] * rs, g1 = acc[ai][0][m][1] * rs, u0 = acc[ai][1][m][0] * rs, u1 = acc[ai][1][m][1] * rs;
                u32x4 w;
                w.x = cvt_pk_bf16(silu_f(g0[0]) * u0[0], silu_f(g0[1]) * u0[1]); w.y = cvt_pk_bf16(silu_f(g0[2]) * u0[2], silu_f(g0[3]) * u0[3]);
                w.z = cvt_pk_bf16(silu_f(g1[0]) * u1[0], silu_f(g1[1]) * u1[1]); w.w = cvt_pk_bf16(silu_f(g1[2]) * u1[2], silu_f(g1[3]) * u1[3]);
                *(u32x4*)rowp = w; }
    }
};
struct EpiResidualBf {
    static constexpr bool PERM = true, AFTER_DRAIN = false;
    bf16_t* x; float scale; float* rss; PG8_LAS float* red;
    __device__ __forceinline__ void operator()(const f32x4 (&acc)[2][2][4][2], const Unit& u, int wr, int wc, int fr, int fq) const {
        const int row0 = u.pm * BM + wr * 64 + fr; const int col0 = u.pn * BM + wc * 32 + 8 * fq;
#pragma unroll
        for (int ai = 0; ai < 2; ++ai)
#pragma unroll
            for (int m = 0; m < 4; ++m) { const int row = row0 + ai * HALF + m * 16; bf16_t* rowp = x + (size_t)row * 1024 + col0; float ss = 0.f;
                const u32x4 b0 = *(const u32x4*)rowp, b1 = *(const u32x4*)(rowp + HALF);
#pragma unroll
                for (int bj = 0; bj < 2; ++bj) { const u32x4 bb = bj ? b1 : b0; const f32x4 a0 = acc[ai][bj][m][0], a1 = acc[ai][bj][m][1];
                    float v[8];
                    v[0] = __builtin_bit_cast(float, bb.x << 16) + scale * a0[0]; v[1] = __builtin_bit_cast(float, bb.x & 0xffff0000u) + scale * a0[1];
                    v[2] = __builtin_bit_cast(float, bb.y << 16) + scale * a0[2]; v[3] = __builtin_bit_cast(float, bb.y & 0xffff0000u) + scale * a0[3];
                    v[4] = __builtin_bit_cast(float, bb.z << 16) + scale * a1[0]; v[5] = __builtin_bit_cast(float, bb.z & 0xffff0000u) + scale * a1[1];
                    v[6] = __builtin_bit_cast(float, bb.w << 16) + scale * a1[2]; v[7] = __builtin_bit_cast(float, bb.w & 0xffff0000u) + scale * a1[3];
                    ss += ((v[0] * v[0] + v[1] * v[1]) + (v[2] * v[2] + v[3] * v[3])) + ((v[4] * v[4] + v[5] * v[5]) + (v[6] * v[6] + v[7] * v[7]));
                    u32x4 w; w.x = cvt_pk_bf16(v[0], v[1]); w.y = cvt_pk_bf16(v[2], v[3]); w.z = cvt_pk_bf16(v[4], v[5]); w.w = cvt_pk_bf16(v[6], v[7]);
                    *(u32x4*)(rowp + bj * HALF) = w; }
                ss += __shfl_xor(ss, 16); ss += __shfl_xor(ss, 32);
                if (fq == 0) red[(ai * HALF + wr * 64 + m * 16 + fr) * 4 + wc] = ss;
                asm volatile("" ::: "memory"); }
        asm volatile("s_waitcnt lgkmcnt(0)" ::: "memory"); __builtin_amdgcn_s_barrier(); asm volatile("" ::: "memory");
        { const int t = threadIdx.x; if (t < 256) { const f32x4 p = *(const PG8_LAS f32x4*)(red + 4 * t); rss[4 * (size_t)(u.pm * BM + t) + u.pn] = (p[0] + p[1]) + (p[2] + p[3]); } }
        asm volatile("s_waitcnt lgkmcnt(0)" ::: "memory"); __builtin_amdgcn_s_barrier(); asm volatile("" ::: "memory");
    }
};
template <class Epi, class Sched, bool ALIGN_EPI = false, bool SP2 = false>
__device__ __forceinline__ void gemm_phase(PG8_LAS unsigned char* lds, const Gemm g, const Sched& S, const Epi& E) {
    int tid_ = threadIdx.x; asm volatile("" : "+v"(tid_));
    const int tid = tid_, wid = __builtin_amdgcn_readfirstlane(tid >> 6), lane = tid & 63, wr = wid >> 2, wc = wid & 3, fr = lane & 15, fq = lane >> 4;
    const int K = g.K, nt = K / BK;
    unsigned voffA[2], voffB[2];
#pragma unroll
    for (int i = 0; i < 2; ++i) { int R, C; stage_rc(tid * 16 + i * 8192, R, C); const int Rb = Epi::PERM ? ((R & ~31) + perm32(R & 31)) : R;
        voffA[i] = (unsigned)(R * K + C) * 2u; voffB[i] = (unsigned)(Rb * K + C) * 2u; }
    const size_t kstep = (size_t)(BK * 2);
    const size_t hstep = (size_t)HALF * K * 2;
    const size_t tstep = 2 * hstep;
    const unsigned ldsw = (unsigned)wid * 1024u;
    const int aoff = lds_byte(wr * 64 + fr, fq * 8), boff = lds_byte(wc * 32 + fr, fq * 8);
#define PG8_SA(b, h) (((b) * 2 + (h)) * HTB)
#define PG8_SB(b, h) ((4 + (b) * 2 + (h)) * HTB)
#define PG8_STAGE(bufoff, gbase, voff) do { _Pragma("unroll") for (int _i = 0; _i < 2; ++_i) \
        __builtin_amdgcn_global_load_lds((const unsigned*)((const char*)(gbase) + (voff)[_i]), (PG8_LAS unsigned*)(lds + (bufoff) + ldsw + _i * 8192), 16, 0, 0); } while (0)
#define PG8_LDA(dst, b, h) do { _Pragma("unroll") for (int m = 0; m < 4; ++m) _Pragma("unroll") for (int k = 0; k < 2; ++k) dst[m][k] = *(const PG8_LAS bf16x8*)(lds + PG8_SA(b, h) + aoff + m * 2048 + k * 1024); } while (0)
#define PG8_LDB(dst, b, h) do { _Pragma("unroll") for (int n = 0; n < 2; ++n) _Pragma("unroll") for (int k = 0; k < 2; ++k) dst[n][k] = *(const PG8_LAS bf16x8*)(lds + PG8_SB(b, h) + boff + n * 2048 + k * 1024); } while (0)
#define PG8_MMA(ai, bj, At, Bt) do { __builtin_amdgcn_s_setprio(1); _Pragma("unroll") for (int m = 0; m < 4; ++m) _Pragma("unroll") for (int n = 0; n < 2; ++n) _Pragma("unroll") for (int k = 0; k < 2; ++k) \
        acc[ai][bj][m][n] = __builtin_amdgcn_mfma_f32_16x16x32_bf16(Bt[n][k], At[m][k], acc[ai][bj][m][n], 0, 0, 0); __builtin_amdgcn_s_setprio(0); } while (0)
#define PG8_WAIT_V(n) asm volatile("s_waitcnt vmcnt(" #n ")" ::: "memory")
#define PG8_WAIT_L(n) asm volatile("s_waitcnt lgkmcnt(" #n ")" ::: "memory")
#define PG8_BAR __builtin_amdgcn_s_barrier()
#define PG8_SCHED __builtin_amdgcn_sched_barrier(0)
    Unit cur, nxt; int ui = 0;
    if (!S.next(0, cur)) return;
    f32x4 acc[2][2][4][2];
#pragma unroll
    for (int a = 0; a < 2; ++a)
#pragma unroll
        for (int b = 0; b < 2; ++b)
#pragma unroll
            for (int m = 0; m < 4; ++m)
#pragma unroll
                for (int n = 0; n < 2; ++n) acc[a][b][m][n] = (f32x4){0.f, 0.f, 0.f, 0.f};
    bf16x8 At[4][2], B0[2][2], B1[2][2];
    const char* cA = (const char*)g.A + (size_t)cur.pm * tstep; const char* cB = (const char*)g.Bt + (size_t)cur.pn * tstep;
    S.a_ready(cur);
    if constexpr (SP2) {
        PG8_STAGE(PG8_SB(0, 0), cB, voffB); PG8_STAGE(PG8_SB(0, 1), cB + hstep, voffB); PG8_STAGE(PG8_SA(0, 0), cA, voffA); PG8_STAGE(PG8_SA(0, 1), cA + hstep, voffA);
        if (wr == 1) PG8_BAR;
        PG8_WAIT_V(2); PG8_BAR;
        PG8_STAGE(PG8_SB(1, 0), cB + kstep, voffB); PG8_STAGE(PG8_SA(1, 0), cA + kstep, voffA); PG8_STAGE(PG8_SB(1, 1), cB + hstep + kstep, voffB);
        PG8_WAIT_V(6); PG8_BAR;
    } else {
        PG8_STAGE(PG8_SB(0, 0), cB, voffB); PG8_STAGE(PG8_SA(0, 0), cA, voffA); PG8_STAGE(PG8_SB(0, 1), cB + hstep, voffB); PG8_STAGE(PG8_SA(0, 1), cA + hstep, voffA);
        if (wr == 1) PG8_BAR;
        PG8_WAIT_V(4); PG8_BAR;
        PG8_STAGE(PG8_SB(1, 0), cB + kstep, voffB); PG8_STAGE(PG8_SA(1, 0), cA + kstep, voffA); PG8_STAGE(PG8_SB(1, 1), cB + hstep + kstep, voffB);
        PG8_WAIT_V(6); PG8_BAR;
    }
    for (;;) {
        const bool has_next = S.next(ui + 1, nxt);
        const char* nA = has_next ? (const char*)g.A + (size_t)nxt.pm * tstep : cA; const char* nB = has_next ? (const char*)g.Bt + (size_t)nxt.pn * tstep : cB;
        for (int t = 0; t < nt; t += 2) {
            const bool last = (t == nt - 2);
            const char* a1 = cA + (size_t)(t + 1) * kstep;
            const char* a2 = last ? nA : cA + (size_t)(t + 2) * kstep; const char* b2 = last ? nB : cB + (size_t)(t + 2) * kstep;
            const char* a3 = a2 + kstep; const char* b3 = b2 + kstep;
            if (last && has_next) S.a_ready(nxt);
            if constexpr (SP2) {
            PG8_LDB(B0, 0, 0); PG8_LDB(B1, 0, 1); PG8_SCHED; PG8_LDA(At, 0, 0); PG8_STAGE(PG8_SA(1, 1), a1 + hstep, voffA);
            PG8_WAIT_V(8); PG8_WAIT_L(0); PG8_BAR; PG8_MMA(0, 0, At, B0); PG8_MMA(0, 1, At, B1); PG8_BAR; PG8_SCHED;
            PG8_LDA(At, 0, 1); PG8_STAGE(PG8_SB(0, 0), b2, voffB); PG8_STAGE(PG8_SB(0, 1), b2 + hstep, voffB); PG8_STAGE(PG8_SA(0, 0), a2, voffA);
            PG8_WAIT_V(8); PG8_WAIT_L(0); PG8_BAR; PG8_MMA(1, 0, At, B0); PG8_MMA(1, 1, At, B1); PG8_BAR; PG8_SCHED;
            PG8_LDB(B0, 1, 0); PG8_LDB(B1, 1, 1); PG8_SCHED; PG8_LDA(At, 1, 0); PG8_STAGE(PG8_SA(0, 1), a2 + hstep, voffA);
            PG8_WAIT_V(8); PG8_WAIT_L(0); PG8_BAR; PG8_MMA(0, 0, At, B0); PG8_MMA(0, 1, At, B1); PG8_BAR; PG8_SCHED;
            PG8_LDA(At, 1, 1); PG8_STAGE(PG8_SB(1, 0), b3, voffB); PG8_STAGE(PG8_SB(1, 1), b3 + hstep, voffB); PG8_STAGE(PG8_SA(1, 0), a3, voffA);
            PG8_WAIT_V(8); PG8_WAIT_L(0); PG8_BAR; PG8_MMA(1, 0, At, B0); PG8_MMA(1, 1, At, B1); PG8_BAR; PG8_SCHED;
            } else {
            PG8_LDB(B0, 0, 0); PG8_SCHED; PG8_LDA(At, 0, 0); PG8_STAGE(PG8_SA(1, 1), a1 + hstep, voffA);
            PG8_WAIT_L(8); PG8_BAR; PG8_WAIT_L(0); PG8_MMA(0, 0, At, B0); PG8_BAR; PG8_SCHED;
            PG8_LDB(B1, 0, 1); PG8_STAGE(PG8_SB(0, 0), b2, voffB);
            PG8_BAR; PG8_WAIT_L(0); PG8_MMA(0, 1, At, B1); PG8_BAR;
            PG8_LDA(At, 0, 1); PG8_STAGE(PG8_SA(0, 0), a2, voffA);
            PG8_BAR; PG8_WAIT_L(0); PG8_MMA(1, 0, At, B0); PG8_BAR; PG8_SCHED;
            PG8_STAGE(PG8_SB(0, 1), b2 + hstep, voffB);
            PG8_WAIT_V(6); PG8_BAR; PG8_MMA(1, 1, At, B1); PG8_BAR;
            PG8_LDB(B0, 1, 0); PG8_SCHED; PG8_LDA(At, 1, 0); PG8_STAGE(PG8_SA(0, 1), a2 + hstep, voffA);
            PG8_WAIT_L(8); PG8_BAR; PG8_WAIT_L(0); PG8_MMA(0, 0, At, B0); PG8_BAR; PG8_SCHED;
            PG8_LDB(B1, 1, 1); PG8_STAGE(PG8_SB(1, 0), b3, voffB);
            PG8_BAR; PG8_WAIT_L(0); PG8_MMA(0, 1, At, B1); PG8_BAR;
            PG8_LDA(At, 1, 1); PG8_STAGE(PG8_SA(1, 0), a3, voffA);
            PG8_BAR; PG8_WAIT_L(0); PG8_MMA(1, 0, At, B0); PG8_BAR; PG8_SCHED;
            PG8_STAGE(PG8_SB(1, 1), b3 + hstep, voffB);
            PG8_WAIT_V(6); PG8_BAR; PG8_MMA(1, 1, At, B1); PG8_BAR;
            }
        }
        if constexpr (ALIGN_EPI) { if (wr == 0) PG8_BAR; }
        if constexpr (!Epi::AFTER_DRAIN) { E(acc, cur, wr, wc, fr, fq); S.done(cur); }
        if (!has_next) break;
#pragma unroll
        for (int a = 0; a < 2; ++a)
#pragma unroll
            for (int b = 0; b < 2; ++b)
#pragma unroll
                for (int m = 0; m < 4; ++m)
#pragma unroll
                    for (int n = 0; n < 2; ++n) acc[a][b][m][n] = (f32x4){0.f, 0.f, 0.f, 0.f};
        cur = nxt; cA = nA; cB = nB; ++ui;
        if constexpr (ALIGN_EPI) { if (wr == 1) PG8_BAR; }
    }
    PG8_WAIT_V(0);
    if constexpr (!ALIGN_EPI) { if (wr == 0) PG8_BAR; }
    PG8_BAR;
    if constexpr (Epi::AFTER_DRAIN) { E.fused(acc, cur, wr, wc, fr, fq, lds, wid, lane); S.done(cur); }
#undef PG8_SA
#undef PG8_SB
#undef PG8_STAGE
#undef PG8_LDA
#undef PG8_LDB
#undef PG8_MMA
#undef PG8_WAIT_V
#undef PG8_WAIT_L
#undef PG8_BAR
#undef PG8_SCHED
}
}
typedef unsigned short bf16_t;
typedef short bf16x8 __attribute__((ext_vector_type(8)));
typedef short s16x4 __attribute__((ext_vector_type(4)));
typedef float f32x4 __attribute__((ext_vector_type(4)));
typedef float f32x16 __attribute__((ext_vector_type(16)));
typedef unsigned u32x4 __attribute__((ext_vector_type(4)));
typedef unsigned u32x2 __attribute__((ext_vector_type(2)));
constexpr int DM = 1024, NB = 4, SEQ = 8192, MTOK = NB * SEQ, DEPTH = 2, DFF = 2816;
constexpr int NH = 8, QKD = 96, VD = 64, INPAD = 1792, NQKV = 1792, KQKV = 384;
constexpr int OFF_KPE = 384, OFF_CONV = 416, OFF_HY = 928;
constexpr float EPS = 1e-6f;
constexpr size_t MiB = 1u << 20;
constexpr size_t WL_GU1 = 0, WL_D1 = WL_GU1 + (size_t)2 * DFF * DM, WL_IN = WL_D1 + (size_t)DM * DFF, WL_QKV = WL_IN + (size_t)INPAD * DM,
                 WL_OUT = WL_QKV + (size_t)NQKV * KQKV, WL_GU2 = WL_OUT + (size_t)DM * DM, WL_D2 = WL_GU2 + (size_t)2 * DFF * DM, WL_END = WL_D2 + (size_t)DM * DFF;
static_assert(WL_END * 2 <= 40 * MiB, "weights per layer");
constexpr size_t WS_RSS = 480 * MiB, WS_W = 1 * MiB, WS_WLAYER = 40 * MiB, WS_ROPE = 81 * MiB, WS_PSUM = 85 * MiB, WS_KK = 86 * MiB, WS_XN = 150 * MiB, WS_ACT = 214 * MiB,
                 WS_Q = WS_ACT, WS_KN = WS_ACT + 48 * MiB, WS_V = WS_ACT + 80 * MiB, WS_A2 = 390 * MiB, WS_UCONV = 414 * MiB, WS_HYT = 430 * MiB, WS_KPE = 478 * MiB, WS_END = 484 * MiB;
constexpr int LDS_BYTES = 150 * 1024;

__device__ __forceinline__ unsigned f2bf(float f) { unsigned u = __builtin_bit_cast(unsigned, f); return (u + 0x7fffu + ((u >> 16) & 1u)) >> 16; }
__device__ __forceinline__ unsigned pk2(float lo, float hi) { return f2bf(lo) | (f2bf(hi) << 16); }
__device__ __forceinline__ float bf2f(unsigned h) { return __builtin_bit_cast(float, h << 16); }
__device__ __forceinline__ float bflo(unsigned w) { return __builtin_bit_cast(float, w << 16); }
__device__ __forceinline__ float bfhi(unsigned w) { return __builtin_bit_cast(float, w & 0xffff0000u); }
__device__ __forceinline__ float wave_sum(float v) {
#pragma unroll
    for (int o = 1; o < 64; o <<= 1) v += __shfl_xor(v, o);
    return v;
}
#define LDS_WAIT() asm volatile("s_waitcnt lgkmcnt(0)" ::: "memory")

#define GAS __attribute__((address_space(1)))
#define LAS __attribute__((address_space(3)))
#define GIN(a, k) ((const float*)(GAS const float*)(a)->in[k])
struct Args { const void* in[34]; float* out; unsigned char* ws; int ph_lo, ph_hi; };
typedef const __attribute__((address_space(4))) Args* ArgsP;
struct Ctx { int tid, lane, wave, G, vcu, gw, NGW; unsigned char* lds; };

__device__ __forceinline__ void tr_matrix(const Ctx& C, const float* W, int K, int N, bf16_t* WT, int ldk, int koff, const float* gain, int mode, int row_off, float gs = 1.0f) {
    float* scr = (float*)(C.lds + C.wave * 8704);
    const int nblk = N / 32, nitems = (K / 64) * nblk, lane = C.lane;
    for (int item = C.gw; item < nitems; item += C.NGW) {
        const int kb = item / nblk, nb = item % nblk, k0 = 64 * kb, n0 = 32 * nb;
        { float tv[32]; const float* wp = W + (size_t)(k0 + (lane >> 5)) * N + n0 + (lane & 31);
#pragma unroll
          for (int i = 0; i < 32; ++i) tv[i] = wp[(size_t)(2 * i) * N];
#pragma unroll
          for (int i = 0; i < 32; ++i) scr[(2 * i + (lane >> 5)) * 33 + (lane & 31)] = tv[i]; }
        LDS_WAIT(); asm volatile("" ::: "memory");
        const int c = lane & 7;
        float g[8];
#pragma unroll
        for (int e = 0; e < 8; ++e) g[e] = gain ? gain[k0 + 8 * c + e] * gs : 1.0f;
        const int drow0 = (mode == 0) ? (row_off + n0) : (256 * (n0 >> 7) + (n0 & 127) + row_off);
#pragma unroll
        for (int j = 0; j < 4; ++j) { const int n = (lane >> 3) + 8 * j; const float* s = scr + (8 * c) * 33 + n;
            u32x4 o; o.x = pk2(s[0 * 33] * g[0], s[1 * 33] * g[1]); o.y = pk2(s[2 * 33] * g[2], s[3 * 33] * g[3]); o.z = pk2(s[4 * 33] * g[4], s[5 * 33] * g[5]); o.w = pk2(s[6 * 33] * g[6], s[7 * 33] * g[7]);
            *(u32x4*)(WT + (size_t)(drow0 + n) * ldk + koff + k0 + 8 * c) = o; }
        LDS_WAIT(); asm volatile("" ::: "memory");
    }
}
__device__ __forceinline__ void p0_weights(const Ctx& C, ArgsP a) {
    for (int ly = 0; ly < DEPTH; ++ly) {
        bf16_t* WB = (bf16_t*)((unsigned char*)(GAS unsigned char*)a->ws + WS_W + (size_t)ly * WS_WLAYER);
        const float* n1 = GIN(a, 2) + ly * DM; const float* nm = GIN(a, 6) + ly * DM; const float* n2 = GIN(a, 29) + ly * DM;
        tr_matrix(C, GIN(a, 3) + (size_t)ly * DM * DFF, DM, DFF, WB + WL_GU1, DM, 0, n1, 1, 0);
        tr_matrix(C, GIN(a, 4) + (size_t)ly * DM * DFF, DM, DFF, WB + WL_GU1, DM, 0, n1, 1, 128);
        tr_matrix(C, GIN(a, 5) + (size_t)ly * DFF * DM, DFF, DM, WB + WL_D1, DFF, 0, nullptr, 0, 0);
        tr_matrix(C, GIN(a, 7) + (size_t)ly * DM * 1696, DM, 1696, WB + WL_IN, DM, 0, nm, 0, 0);
        tr_matrix(C, GIN(a, 9) + (size_t)ly * 256 * 768, 256, 768, WB + WL_QKV, KQKV, 0, GIN(a, 8) + ly * 256, 0, 0, 0.10206207261596575f * 1.4426950408889634f);
        tr_matrix(C, GIN(a, 11) + (size_t)ly * 128 * 1024, 128, 1024, WB + WL_QKV, KQKV, 256, GIN(a, 10) + ly * 128, 0, 768);
        tr_matrix(C, GIN(a, 28) + (size_t)ly * DM * DM, DM, DM, WB + WL_OUT, DM, 0, GIN(a, 27) + ly * DM, 0, 0);
        tr_matrix(C, GIN(a, 30) + (size_t)ly * DM * DFF, DM, DFF, WB + WL_GU2, DM, 0, n2, 1, 0);
        tr_matrix(C, GIN(a, 31) + (size_t)ly * DM * DFF, DM, DFF, WB + WL_GU2, DM, 0, n2, 1, 128);
        tr_matrix(C, GIN(a, 32) + (size_t)ly * DFF * DM, DFF, DM, WB + WL_D2, DFF, 0, nullptr, 0, 0);
        const int gt = C.vcu * 512 + C.tid, GT = C.G * 512;
        for (int i = gt; i < 96 * DM / 8; i += GT) *(u32x4*)(WB + WL_IN + (size_t)1696 * DM + (size_t)i * 8) = (u32x4){0u, 0u, 0u, 0u};
        for (int i = gt; i < 768 * 16; i += GT) { const int r = i >> 4, cc = i & 15; *(u32x4*)(WB + WL_QKV + (size_t)r * KQKV + 256 + cc * 8) = (u32x4){0u, 0u, 0u, 0u}; }
        for (int i = gt; i < 1024 * 32; i += GT) { const int r = 768 + (i >> 5), cc = i & 31; *(u32x4*)(WB + WL_QKV + (size_t)r * KQKV + cc * 8) = (u32x4){0u, 0u, 0u, 0u}; }
    }
    { float* cs = (float*)((unsigned char*)(GAS unsigned char*)a->ws + WS_ROPE); const int* pos = (const int*)(GAS const int*)a->in[1];
      const int gt = C.vcu * 512 + C.tid, GT = C.G * 512;
      for (int idx = gt; idx < MTOK * 16; idx += GT) { const int row = idx >> 4, i = idx & 15;
          double f = 1.0; for (int e = 0; e < i; ++e) f *= 0.5623413251903491;
          const double rev = (double)pos[row] * f * 0.15915494309189535; const float fr = (float)(rev - __builtin_rint(rev));
          cs[(size_t)row * 32 + i] = __builtin_amdgcn_cosf(fr); cs[(size_t)row * 32 + 16 + i] = __builtin_amdgcn_sinf(fr); } }
}
__device__ __forceinline__ float sin_rev(float x) { return __builtin_amdgcn_sinf(x * 0.15915494309189535f); }
__device__ __forceinline__ void hyena_filter_item(const Ctx& C, ArgsP a, int ly, int ch) {
    float* zf = (float*)C.lds;
    float* hA = zf + 64 * 36;
    float* hB = hA + 64 * 68;
    float* ps = hB + 64 * 68;
    const int tid = C.tid; const int l0 = ch * 64;
    const float* w1 = GIN(a, 18) + ly * 33 * 64; const float* b1 = GIN(a, 19) + ly * 64;
    const float* w2 = GIN(a, 20) + ly * 64 * 64; const float* b2 = GIN(a, 21) + ly * 64;
    const float* w3 = GIN(a, 22) + ly * 64 * 64; const float* b3 = GIN(a, 23) + ly * 64;
    const float* w4 = GIN(a, 24) + (size_t)ly * 64 * 1024; const float* frq = GIN(a, 25) + ly * 64;
    __syncthreads();
    for (int idx = tid; idx < 64 * 36; idx += 512) { const int p = idx / 36, f = idx - 36 * p; const int l = l0 + p; float v;
        if (f >= 33) v = 0.f;
        else if (f == 0) v = (float)l / 8191.0f;
        else { const int bi = (f - 1) & 15; const float fb = 1e-4f + (float)bi * ((15.0f - 1e-4f) / 15.0f); const float rev = fb * ((float)l / 8192.0f);
            v = (f <= 16) ? __builtin_amdgcn_cosf(rev) : -__builtin_amdgcn_sinf(rev); }
        zf[p * 36 + f] = v; }
    __syncthreads();
    { const int u = tid & 63; const float fr = frq[u], bb = b1[u]; float wr_[36];
#pragma unroll
      for (int f = 0; f < 36; ++f) wr_[f] = (f < 33) ? w1[f * 64 + u] : 0.f;
#pragma unroll 1
      for (int p = tid >> 6; p < 64; p += 8) { float s = bb;
#pragma unroll
          for (int f4 = 0; f4 < 9; ++f4) { const f32x4 z = *(const f32x4*)(zf + p * 36 + 4 * f4); s += z[0] * wr_[4 * f4] + z[1] * wr_[4 * f4 + 1] + z[2] * wr_[4 * f4 + 2] + z[3] * wr_[4 * f4 + 3]; }
          hA[p * 68 + u] = sin_rev(fr * s); } }
    __syncthreads();
    { const int u = tid & 63; const float fr = frq[u], bb = b2[u]; float wr_[64];
#pragma unroll
      for (int f = 0; f < 64; ++f) wr_[f] = w2[f * 64 + u];
#pragma unroll 1
      for (int p = tid >> 6; p < 64; p += 8) { float s = bb;
#pragma unroll
          for (int f4 = 0; f4 < 16; ++f4) { const f32x4 z = *(const f32x4*)(hA + p * 68 + 4 * f4); s += z[0] * wr_[4 * f4] + z[1] * wr_[4 * f4 + 1] + z[2] * wr_[4 * f4 + 2] + z[3] * wr_[4 * f4 + 3]; }
          hB[p * 68 + u] = sin_rev(fr * s); } }
    __syncthreads();
    { const int u = tid & 63; const float fr = frq[u], bb = b3[u]; float wr_[64];
#pragma unroll
      for (int f = 0; f < 64; ++f) wr_[f] = w3[f * 64 + u];
#pragma unroll 1
      for (int p = tid >> 6; p < 64; p += 8) { float s = bb;
#pragma unroll
          for (int f4 = 0; f4 < 16; ++f4) { const f32x4 z = *(const f32x4*)(hB + p * 68 + 4 * f4); s += z[0] * wr_[4 * f4] + z[1] * wr_[4 * f4 + 1] + z[2] * wr_[4 * f4 + 2] + z[3] * wr_[4 * f4 + 3]; }
          hA[u * 68 + p] = sin_rev(fr * s); } }
    __syncthreads();
    const int c = tid & 255, phh = tid >> 8;
    const float adelta = 3.0701134573253945f + (float)c * ((15.350567286626973f - 3.0701134573253945f) / 255.0f);
    float* raw = (float*)((unsigned char*)(GAS unsigned char*)a->ws + WS_KK); float* psum = (float*)((unsigned char*)(GAS unsigned char*)a->ws + WS_PSUM);
    float* W4s = (float*)(C.lds + 49152);
#pragma unroll 1
    for (int q = 0; q < 4; ++q) {
#pragma unroll
        for (int it = 0; it < 8; ++it) { const int i = tid + it * 512; const int k = i >> 6, c4 = i & 63; *(f32x4*)(W4s + k * 256 + 4 * c4) = *(const f32x4*)(w4 + (size_t)k * 1024 + q * 256 + 4 * c4); }
        __syncthreads();
        float s = 0.f;
        float* dst = raw + ((size_t)((ly * 4 + q) * 256 + c)) * 8192 + l0 + 32 * phh;
#pragma unroll 1
        for (int half = 0; half < 2; ++half) {
            float acc[16];
#pragma unroll
            for (int p = 0; p < 16; ++p) acc[p] = 0.f;
            const float* hp = hA + 32 * phh + 16 * half;
#pragma unroll 4
            for (int k = 0; k < 64; ++k) { const float w = W4s[k * 256 + c];
                const f32x4 h0 = *(const f32x4*)(hp + k * 68), h1 = *(const f32x4*)(hp + k * 68 + 4), h2 = *(const f32x4*)(hp + k * 68 + 8), h3 = *(const f32x4*)(hp + k * 68 + 12);
#pragma unroll
                for (int e = 0; e < 4; ++e) { acc[e] += h0[e] * w; acc[4 + e] += h1[e] * w; acc[8 + e] += h2[e] * w; acc[12 + e] += h3[e] * w; } }
#pragma unroll
            for (int p = 0; p < 16; ++p) { const int l = l0 + 32 * phh + 16 * half + p; const float t = (float)l / 8191.0f; acc[p] *= __expf(-t * adelta); if (!((q & 1) && l == 0)) s += fabsf(acc[p]); }
#pragma unroll
            for (int p = 0; p < 16; p += 4) *(f32x4*)(dst + 16 * half + p) = (f32x4){acc[p], acc[p + 1], acc[p + 2], acc[p + 3]};
        }
        if (phh == 1) ps[c] = s;
        __syncthreads();
        if (phh == 0) psum[((size_t)(ly * 128 + ch)) * 1024 + q * 256 + c] = s + ps[c];
    }
}
__device__ __forceinline__ void cast_rows(const Ctx& C, const float* x, bf16_t* xb, float* rss) {
    for (int m = C.gw; m < MTOK; m += C.NGW) {
        const f32x4* xr = (const f32x4*)(x + (size_t)m * DM) + C.lane; f32x4 v[4]; float s = 0.f;
#pragma unroll
        for (int j = 0; j < 4; ++j) { v[j] = xr[64 * j]; s += (v[j].x * v[j].x + v[j].y * v[j].y) + (v[j].z * v[j].z + v[j].w * v[j].w); }
        s = wave_sum(s); if (C.lane == 0) *(f32x4*)(rss + 4 * (size_t)m) = (f32x4){s, 0.f, 0.f, 0.f};
        u32x2* o8 = (u32x2*)(xb + (size_t)m * DM) + C.lane;
#pragma unroll
        for (int j = 0; j < 4; ++j) o8[64 * j] = (u32x2){pk2(v[j].x, v[j].y), pk2(v[j].z, v[j].w)};
    }
}
__device__ __forceinline__ void final_norm_rows(const Ctx& C, const bf16_t* xb, const float* rss, float* out, const float* g) {
    f32x4 gg[4];
#pragma unroll
    for (int j = 0; j < 4; ++j) gg[j] = ((const f32x4*)g)[C.lane + 64 * j];
    for (int m = C.gw; m < MTOK; m += 2 * C.NGW) {
        const int m2 = (m + C.NGW < MTOK) ? m + C.NGW : m;
        const u32x2* xr = (const u32x2*)(xb + (size_t)m * DM) + C.lane; const u32x2* xr2 = (const u32x2*)(xb + (size_t)m2 * DM) + C.lane; u32x2 v[4], w[4];
        const f32x4 s1 = *(const f32x4*)(rss + 4 * (size_t)m), s2 = *(const f32x4*)(rss + 4 * (size_t)m2);
#pragma unroll
        for (int j = 0; j < 4; ++j) { v[j] = xr[64 * j]; w[j] = xr2[64 * j]; }
        const float rstd = rsqrtf(((s1[0] + s1[1]) + (s1[2] + s1[3])) * (1.f / DM) + EPS), rstd2 = rsqrtf(((s2[0] + s2[1]) + (s2[2] + s2[3])) * (1.f / DM) + EPS);
        f32x4* o1 = (f32x4*)(out + (size_t)m * DM) + C.lane; f32x4* o2 = (f32x4*)(out + (size_t)m2 * DM) + C.lane;
#pragma unroll
        for (int j = 0; j < 4; ++j) o1[64 * j] = (f32x4){bflo(v[j].x), bfhi(v[j].x), bflo(v[j].y), bfhi(v[j].y)} * rstd * gg[j];
        if (m2 != m) {
#pragma unroll
            for (int j = 0; j < 4; ++j) o2[64 * j] = (f32x4){bflo(w[j].x), bfhi(w[j].x), bflo(w[j].y), bfhi(w[j].y)} * rstd2 * gg[j]; }
    }
}
__device__ __forceinline__ void group_norm_tile(const Ctx& C, bf16_t* y, const bf16_t* yhyT, int tile) {
    constexpr int TS = 72;
    bf16_t* T = (bf16_t*)C.lds;
    const int tid = C.tid, lane = C.lane; const int row0 = tile * 64; const int b = row0 >> 13, l0 = row0 & 8191;
    __syncthreads();
    { const int c = tid >> 1, hf = tid & 1; const bf16_t* src = yhyT + ((size_t)(b * 256 + c)) * SEQ + l0 + hf * 32;
      u32x4 v[4];
#pragma unroll
      for (int e = 0; e < 4; ++e) v[e] = *(const u32x4*)(src + 8 * e);
#pragma unroll
      for (int e = 0; e < 4; ++e) *(u32x4*)(T + c * TS + hf * 32 + 8 * e) = v[e]; }
    __syncthreads();
#pragma unroll 2
    for (int p = C.wave * 8; p < C.wave * 8 + 8; ++p) {
        u32x2* yr = (u32x2*)(y + (size_t)(row0 + p) * DM) + lane; float v[4][4]; float ss[4];
#pragma unroll
        for (int j = 0; j < 3; ++j) { const u32x2 w = yr[64 * j]; v[j][0] = bflo(w.x); v[j][1] = bfhi(w.x); v[j][2] = bflo(w.y); v[j][3] = bfhi(w.y); }
#pragma unroll
        for (int e = 0; e < 4; ++e) v[3][e] = bf2f(T[(4 * lane + e) * TS + p]);
#pragma unroll
        for (int j = 0; j < 4; ++j) ss[j] = (v[j][0] * v[j][0] + v[j][1] * v[j][1]) + (v[j][2] * v[j][2] + v[j][3] * v[j][3]);
        const float s0 = wave_sum(ss[0] + ss[1]), s1 = wave_sum(ss[2]), s2 = wave_sum(ss[3]);
        float r[4]; r[0] = r[1] = rsqrtf(s0 * (1.f / 512.f) + EPS); r[2] = rsqrtf(s1 * (1.f / 256.f) + EPS); r[3] = rsqrtf(s2 * (1.f / 256.f) + EPS);
#pragma unroll
        for (int j = 0; j < 4; ++j) yr[64 * j] = (u32x2){pk2(v[j][0] * r[j], v[j][1] * r[j]), pk2(v[j][2] * r[j], v[j][3] * r[j])};
    }
}
__device__ __forceinline__ void prep_rows(const Ctx& C, const bf16_t* h, bf16_t* A2, bf16_t* kper, bf16_t* uconv, const float* cs) {
    const int lane = C.lane;
    struct RowIn { u32x2 wq, wa, wg; unsigned wkv; float x1, x2, c, s; };
    auto ld = [&](int m) { RowIn r; const bf16_t* hp = h + (size_t)m * INPAD;
        r.wq = *((const u32x2*)hp + lane); r.wkv = *((const unsigned*)(hp + 256) + lane);
        r.wa = *((const u32x2*)(hp + OFF_CONV) + lane); r.wg = *((const u32x2*)(hp + OFF_CONV + 256) + lane);
        const int l16 = lane & 15; r.x1 = bf2f(hp[OFF_KPE + l16]); r.x2 = bf2f(hp[OFF_KPE + 16 + l16]); r.c = cs[(size_t)m * 32 + l16]; r.s = cs[(size_t)m * 32 + 16 + l16]; return r; };
    int m = C.gw; if (m >= MTOK) return;
    RowIn cur = ld(m);
    for (; m < MTOK; m += C.NGW) {
        const int mn = (m + C.NGW < MTOK) ? m + C.NGW : m;
        const RowIn nxt = ld(mn);
        const u32x2 wq = cur.wq, wa = cur.wa, wg = cur.wg; const unsigned wkv = cur.wkv;
        const float q0 = bflo(wq.x), q1 = bfhi(wq.x), q2 = bflo(wq.y), q3 = bfhi(wq.y), k0 = bflo(wkv), k1 = bfhi(wkv);
        const float rq = rsqrtf(wave_sum((q0 * q0 + q1 * q1) + (q2 * q2 + q3 * q3)) * (1.f / 256.f) + EPS);
        const float rk = rsqrtf(wave_sum(k0 * k0 + k1 * k1) * (1.f / 128.f) + EPS);
        *((u32x2*)(A2 + (size_t)m * KQKV) + lane) = (u32x2){pk2(q0 * rq, q1 * rq), pk2(q2 * rq, q3 * rq)};
        *((unsigned*)(A2 + (size_t)m * KQKV + 256) + lane) = pk2(k0 * rk, k1 * rk);
        { const float a0 = bflo(wa.x), a1 = bfhi(wa.x), a2 = bflo(wa.y), a3 = bfhi(wa.y), g0 = bflo(wg.x), g1 = bfhi(wg.x), g2 = bflo(wg.y), g3 = bfhi(wg.y);
          *((u32x2*)(uconv + (size_t)m * 256) + lane) = (u32x2){pk2(a0 / (1.f + __expf(-g0)), a1 / (1.f + __expf(-g1))), pk2(a2 / (1.f + __expf(-g2)), a3 / (1.f + __expf(-g3)))}; }
        if (lane < 16) { kper[(size_t)m * 32 + lane] = (bf16_t)f2bf(cur.x1 * cur.c - cur.x2 * cur.s); kper[(size_t)m * 32 + 16 + lane] = (bf16_t)f2bf(cur.x1 * cur.s + cur.x2 * cur.c); }
        cur = nxt;
    }
}
__device__ __forceinline__ void hy_short_tile(const Ctx& C, const bf16_t* h, bf16_t* hyT, const float* sw, const float* sb, int tile) {
    constexpr int RS = 776;
    bf16_t* T = (bf16_t*)C.lds;
    const int tid = C.tid; const int row0 = tile * 64; const int b = row0 >> 13, l0 = row0 & 8191;
    __syncthreads();
#pragma unroll 4
    for (int i = tid; i < 66 * 96; i += 512) { const int r = i / 96, cc = i - 96 * r; const int l = l0 - 1 + r;
        u32x4 v = (u32x4){0u, 0u, 0u, 0u}; if (l >= 0 && l < SEQ) v = *(const u32x4*)(h + (size_t)(b * SEQ + l) * INPAD + OFF_HY + cc * 8);
        *(u32x4*)(T + r * RS + cc * 8) = v; }
    __syncthreads();
    for (int w = tid; w < 768 * 8; w += 512) { const int pg = w & 7, ch = w >> 3;
        const float w0 = sw[ch], w1 = sw[768 + ch], w2 = sw[1536 + ch], bb = sb[ch];
        float x[10];
#pragma unroll
        for (int r = 0; r < 10; ++r) x[r] = bf2f(T[(8 * pg + r) * RS + ch]);
        u32x4 o; o.x = pk2(bb + w0 * x[0] + w1 * x[1] + w2 * x[2], bb + w0 * x[1] + w1 * x[2] + w2 * x[3]); o.y = pk2(bb + w0 * x[2] + w1 * x[3] + w2 * x[4], bb + w0 * x[3] + w1 * x[4] + w2 * x[5]);
        o.z = pk2(bb + w0 * x[4] + w1 * x[5] + w2 * x[6], bb + w0 * x[5] + w1 * x[6] + w2 * x[7]); o.w = pk2(bb + w0 * x[6] + w1 * x[7] + w2 * x[8], bb + w0 * x[7] + w1 * x[8] + w2 * x[9]);
        const int g = ch >> 8, cc = ch & 255;
        *(u32x4*)(hyT + ((size_t)((g * NB + b) * 256 + cc)) * SEQ + l0 + 8 * pg) = o; }
}
__device__ __forceinline__ void conv_tile(const Ctx& C, const bf16_t* uconv, bf16_t* y, const float* dw, const float* db, const float* lg, const float* lb, int tile) {
    bf16_t* U = (bf16_t*)C.lds;
    float* O = (float*)(C.lds + 94 * 512);
    const int tid = C.tid; const int row0 = tile * 64; const int b = row0 >> 13, l0 = row0 & 8191;
    __syncthreads();
#pragma unroll 6
    for (int i = tid; i < 94 * 32; i += 512) { const int r = i >> 5, cc = i & 31; const int l = l0 - 15 + r;
        u32x4 v = (u32x4){0u, 0u, 0u, 0u}; if (l >= 0 && l < SEQ) v = *(const u32x4*)(uconv + (size_t)(b * SEQ + l) * 256 + cc * 8);
        *(u32x4*)(U + r * 256 + cc * 8) = v; }
    __syncthreads();
    { const int c = tid & 255, phh = tid >> 8;
      float w[31], acc[32];
#pragma unroll
      for (int j = 0; j < 31; ++j) w[j] = dw[j * 256 + c];
      const float bb = db[c];
#pragma unroll
      for (int p = 0; p < 32; ++p) acc[p] = bb;
#pragma unroll
      for (int q = 0; q < 62; ++q) { const float val = bf2f(U[(32 * phh + q) * 256 + c]);
#pragma unroll
          for (int p = 0; p < 32; ++p) if (q - p >= 0 && q - p <= 30) acc[p] += w[q - p] * val; }
#pragma unroll
      for (int p = 0; p < 32; ++p) O[(32 * phh + p) * 260 + c] = acc[p]; }
    __syncthreads();
    { const int lane = C.lane; const f32x4 gg = ((const f32x4*)lg)[lane], be = ((const f32x4*)lb)[lane];
      for (int p = C.wave * 8; p < C.wave * 8 + 8; ++p) { const f32x4 v = *(const f32x4*)(O + p * 260 + 4 * lane);
          const float mean = wave_sum((v[0] + v[1]) + (v[2] + v[3])) * (1.f / 256.f); const f32x4 d = v - mean;
          const float rstd = rsqrtf(wave_sum((d[0] * d[0] + d[1] * d[1]) + (d[2] * d[2] + d[3] * d[3])) * (1.f / 256.f) + EPS);
          const f32x4 t = d * rstd * gg + be; float o[4];
#pragma unroll
          for (int e = 0; e < 4; ++e) o[e] = t[e] / (1.f + __expf(-t[e]));
          *((u32x2*)(y + (size_t)(row0 + p) * DM + 512) + lane) = (u32x2){pk2(o[0], o[1]), pk2(o[2], o[3])}; } }
}
__device__ __forceinline__ void hyena_item(const Ctx& C, ArgsP a, int ly, int c, bf16_t* yout) {
    constexpr int US = 144, DG = 8, WW = 128 * DG + 144;
    constexpr int OFF_R = 4 * 64 * US * 2, OFF_W = OFF_R + 32768, OFF_RED = OFF_W + 2 * 8 * WW * 2;
    bf16_t* U = (bf16_t*)C.lds;
    bf16_t* R = (bf16_t*)(C.lds + OFF_R);
    bf16_t* Wn = (bf16_t*)(C.lds + OFF_W);
    float* red = (float*)(C.lds + OFF_RED);
    typedef float f32x4v __attribute__((ext_vector_type(4)));
    const int tid = C.tid, lane = C.lane, wave = C.wave; const int b = wave & 3, rh = wave >> 2; const int col = lane & 15, kq = lane >> 4;
    unsigned char* wsb = (unsigned char*)(GAS unsigned char*)a->ws;
    const bf16_t* hyT = (const bf16_t*)(wsb + WS_HYT);
    const float* raw = (const float*)(wsb + WS_KK); const float* psum = (const float*)(wsb + WS_PSUM);
    __syncthreads();
    { const bf16_t* vsrc = hyT + (size_t)c * SEQ + tid * 8; bf16_t* udst = U + (tid >> 4) * US + (tid & 15) * 8;
#pragma unroll
      for (int it = 0; it < 8; ++it) { const u32x4 v = *(const u32x4*)(vsrc + (size_t)(it >> 1) * 256 * SEQ + (it & 1) * 4096);
          *(u32x4*)(udst + ((it >> 1) * 64 + (it & 1) * 32) * US) = v; } }
    const int abase = (col & 7) * WW + 128 + 8 * kq - 8 * (col >> 3) - 64 * rh;
    for (int o = 0; o < 2; ++o) {
        { float v = 0.f; if (tid < 256) v = psum[((size_t)(ly * 128 + (tid & 127))) * 1024 + o * 512 + (tid >> 7) * 256 + c];
          v = wave_sum(v); if (lane == 0) red[wave] = v; }
        __syncthreads();
        const float inv = 1.0f / ((red[0] + red[1]) + (red[2] + red[3]));
        const float dbias = GIN(a, 26)[(ly * 2 + o) * 256 + c];
        const float* rf = raw + ((size_t)((ly * 4 + o * 2 + 0) * 256 + c)) * 8192; const float* rb = raw + ((size_t)((ly * 4 + o * 2 + 1) * 256 + c)) * 8192;
        { f32x4 vf[4], vb[4];
#pragma unroll
          for (int it = 0; it < 4; ++it) { vf[it] = *(const f32x4*)(rf + 4 * (tid + it * 512)); vb[it] = *(const f32x4*)(rb + 4 * (tid + it * 512)); }
#pragma unroll
          for (int it = 0; it < 4; ++it)
#pragma unroll
              for (int e = 0; e < 4; ++e) { const int l = 4 * (tid + it * 512) + e; float f = vf[it][e] * inv; if (l == 0) f += dbias;
                  R[8192 - l] = (bf16_t)f2bf(f); if (l >= 1) R[8192 + l] = (bf16_t)f2bf(vb[it][e] * inv); else R[0] = 0; } }
        f32x4v acc[4][4];
#pragma unroll
        for (int i = 0; i < 4; ++i)
#pragma unroll
            for (int j = 0; j < 4; ++j) acc[i][j] = (f32x4v){0.f, 0.f, 0.f, 0.f};
        __syncthreads();
        for (int g = 0; g < 128 / DG; ++g) {
            const int dlo = -64 + DG * g, dhi = dlo + DG - 1;
            bf16_t* Wb = Wn + (g & 1) * (8 * WW);
            const int xs = 8192 - 128 * dhi - 128;
            { bf16_t* dst = Wb + wave * WW; const int x0 = xs - wave;
#pragma unroll 4
              for (int yy = lane; yy < WW; yy += 64) { const int xi = x0 + yy; dst[yy] = (xi >= 0 && xi < 16384) ? R[xi] : (bf16_t)0; } }
            __syncthreads();
#define HY_MMA(CT) { const int s1 = 16 * (CT) + col - d; const bool ok = (s1 >= 0 && s1 < 64); const bf16_t* up = U + (b * 64 + (ok ? s1 : 0)) * US + 8 * kq; \
            bf16x8 bvs[4]; \
            _Pragma("unroll") for (int jj = 0; jj < 4; ++jj) bvs[jj] = *(const bf16x8*)(up + 32 * jj); \
            __builtin_amdgcn_sched_barrier(0); __builtin_amdgcn_s_setprio(1); \
            _Pragma("unroll") for (int jj = 0; jj < 4; ++jj) { bf16x8 bv = bvs[jj]; if (!ok) bv = (bf16x8){0, 0, 0, 0, 0, 0, 0, 0}; \
                _Pragma("unroll") for (int ii = 0; ii < 4; ++ii) acc[ii][CT] = __builtin_amdgcn_mfma_f32_16x16x32_bf16(fa[2 * jj - ii + 3], bv, acc[ii][CT], 0, 0, 0); } \
            __builtin_amdgcn_s_setprio(0); }
            for (int dd = 0; dd < DG; ++dd) { const int d = dlo + dd; if (d == -64) continue;
                const bf16_t* Wd = Wb + abase + 128 * (DG - 1 - dd);
                bf16x8 fa[10];
#pragma unroll
                for (int q = 0; q < 10; ++q) fa[q] = *(const bf16x8*)(Wd + 16 * (q - 3));
                if (d <= 15) HY_MMA(0)
                if (d >= -47 && d <= 31) HY_MMA(1)
                if (d >= -31 && d <= 47) HY_MMA(2)
                if (d >= -15) HY_MMA(3)
            }
#undef HY_MMA
        }
        __syncthreads();
        const bf16_t* xg = hyT + ((size_t)(((o + 1) * NB + b) * 256 + c)) * SEQ + col * 128 + 4 * kq + 64 * rh;
        bf16_t* Ul = U + (b * 64 + col) * US + 4 * kq + 64 * rh;
#pragma unroll
        for (int ct = 0; ct < 4; ++ct) {
#pragma unroll
            for (int ii = 0; ii < 4; ++ii)
#pragma unroll
                for (int r = 0; r < 4; ++r) { const float val = bf2f(xg[2048 * ct + 16 * ii + r]) * acc[ii][ct][r]; Ul[16 * ct * US + 16 * ii + r] = (bf16_t)f2bf(val); }
            asm volatile("" ::: "memory"); }
        __syncthreads();
        if (o == 1) {
            bf16_t* ydst = yout + (size_t)c * SEQ + tid * 8; const bf16_t* usrc = U + (tid >> 4) * US + (tid & 15) * 8;
#pragma unroll
            for (int it = 0; it < 8; ++it) *(u32x4*)(ydst + (size_t)(it >> 1) * 256 * SEQ + (it & 1) * 4096) = *(const u32x4*)(usrc + ((it >> 1) * 64 + (it & 1) * 32) * US);
        }
    }
}
#define XB_TMO      128
#define XB_XCNT(j)  (256  + 64 * (j))
#define XB_XSUB(j)  (1280 + 64 * (j))
#define XB_XGEN(j)  (2304 + 64 * (j))
#define XB_TOP      3328
#define XB_TOPGEN   3392
#define XCD_BAR_WORDS 3456
#define XB_SPIN_CAP (1u << 18)

__device__ __forceinline__ unsigned xb_ld(unsigned* p)              { return __hip_atomic_load(p, __ATOMIC_RELAXED, __HIP_MEMORY_SCOPE_AGENT); }
__device__ __forceinline__ unsigned xb_add(unsigned* p, unsigned v) { return __hip_atomic_fetch_add(p, v, __ATOMIC_RELAXED, __HIP_MEMORY_SCOPE_AGENT); }
__device__ __forceinline__ unsigned xb_xcc_id() { return (unsigned)__builtin_amdgcn_s_getreg((3 << 11) | 20) & 0xFu; }
#define XB_SPIN(cond, bar) do { unsigned _sp = 0; while (cond) { __builtin_amdgcn_s_sleep(1); \
    if ((++_sp & 255u) == 0u) { if (xb_ld(&(bar)[XB_TMO])) break; if (_sp > XB_SPIN_CAP) { atomicAdd(&(bar)[XB_TMO], 1u); break; } } } } while (0)

struct XcdBarrier {
    unsigned* bar; unsigned x;
    volatile LAS unsigned* st;
};

__device__ __forceinline__ XcdBarrier xcd_barrier_post(unsigned* bar, volatile LAS unsigned* st) {
    XcdBarrier b; b.bar = bar; b.x = xb_xcc_id(); b.st = st;
    if (threadIdx.x == 0) (void)xb_add(&bar[XB_XCNT(b.x)], 1u);
    return b;
}
__device__ __forceinline__ void xcd_barrier_complete(unsigned* bar, unsigned x, unsigned& nloc, unsigned& nx) {
    const unsigned G = gridDim.x * gridDim.y * gridDim.z;
    unsigned sum, cnt, mine, sp = 0u;
    for (;;) {
        sum = 0u; cnt = 0u; mine = 0u;
#pragma unroll
        for (unsigned j = 0; j < 16; ++j) { const unsigned c = xb_ld(&bar[XB_XCNT(j)]); sum += c; cnt += (c > 0u) ? 1u : 0u; mine = (j == x) ? c : mine; }
        if (sum == G) break;
        __builtin_amdgcn_s_sleep(1);
        if ((++sp & 255u) == 0u) { if (xb_ld(&bar[XB_TMO])) break; if (sp > XB_SPIN_CAP) { atomicAdd(&bar[XB_TMO], 1u); break; } }
    }
    nloc = mine > 0u ? mine : 1u; nx = cnt > 0u ? cnt : 1u;
}

__device__ __forceinline__ void xcd_barrier(const XcdBarrier& b) {
    asm volatile("s_waitcnt vmcnt(0)" ::: "memory");
    __syncthreads();
    if (threadIdx.x == 0) {
        unsigned* bar = b.bar;
        __builtin_amdgcn_s_waitcnt(0);
        unsigned nloc = b.st[0], nx = b.st[1];
        if (nloc == 0u) { xcd_barrier_complete(bar, b.x, nloc, nx); b.st[0] = nloc; b.st[1] = nx; }
        const unsigned old = xb_add(&bar[XB_XSUB(b.x)], 1u);
        const unsigned gen = old / nloc;
        if (old + 1u == (gen + 1u) * nloc) {
            __builtin_amdgcn_fence(__ATOMIC_RELEASE, "agent");
            asm volatile("s_waitcnt vmcnt(0)" ::: "memory");
            const unsigned og = xb_add(&bar[XB_TOP], 1u);
            const unsigned tg = og / nx;
            if (og + 1u == (tg + 1u) * nx) xb_add(&bar[XB_TOPGEN], 1u);
            else XB_SPIN(xb_ld(&bar[XB_TOPGEN]) == tg, bar);
            __builtin_amdgcn_fence(__ATOMIC_ACQUIRE, "agent");
            xb_add(&bar[XB_XGEN(b.x)], 1u);
            asm volatile("s_waitcnt vmcnt(0)" ::: "memory");
        } else {
            XB_SPIN(xb_ld(&bar[XB_XGEN(b.x)]) == gen, bar);
            __builtin_amdgcn_fence(__ATOMIC_ACQUIRE, "agent");
            asm volatile("s_waitcnt vmcnt(0)" ::: "memory");
        }
    }
    __syncthreads();
}

namespace att {
constexpr int QBLK = 32, KVBLK = 64;
constexpr float SCALE = 0.10206207261596575f;
constexpr float THR = 8.f;
constexpr int SHM_V = 16384, SHM_K = 16384, SLOT = 16384;
#define KSWZ(row, colB) ((row) * 256 + ((colB) ^ (((row) & 7) << 4)))
#define SBAR() __builtin_amdgcn_sched_barrier(0)
__device__ __forceinline__ int crow(int r, int hi) { return (r & 3) + 8 * (r >> 2) + 4 * hi; }
__device__ __forceinline__ unsigned cvtpk(float lo, float hi) { unsigned r; asm volatile("v_cvt_pk_bf16_f32 %0, %1, %2" : "=v"(r) : "v"(lo), "v"(hi)); return r; }
constexpr float THRL = 8.f * 1.4426950408889634f;
template <bool FIRST> __device__ __forceinline__ void partialSM(f32x16& p0, f32x16& p1, float& mhat, f32x16& negm, float& alpha) {
  float pa = fmaxf(fmaxf(p0[0], p0[1]), p1[0]), pb = fmaxf(fmaxf(p0[2], p0[3]), p1[1]); pa = fmaxf(fmaxf(pa, p1[2]), p1[3]);
#pragma unroll
  for (int r = 4; r < 16; r += 4) { pa = fmaxf(fmaxf(pa, p0[r]), p0[r + 1]); pb = fmaxf(fmaxf(pb, p0[r + 2]), p0[r + 3]); pa = fmaxf(fmaxf(pa, p1[r]), p1[r + 1]); pb = fmaxf(fmaxf(pb, p1[r + 2]), p1[r + 3]); }
  float pmax = fmaxf(pa, pb);
  { auto rr = __builtin_amdgcn_permlane32_swap(__float_as_uint(pmax), __float_as_uint(pmax), false, false);
    pmax = fmaxf(__uint_as_float(rr[0]), __uint_as_float(rr[1])); }
  if (!FIRST && __builtin_expect(__all(pmax <= THRL), 1)) { alpha = 1.f; }
  else { const float d = FIRST ? pmax : fmaxf(pmax, 0.f); mhat += d; alpha = FIRST ? 1.f : __builtin_amdgcn_exp2f(-d);
#pragma unroll
    for (int r = 0; r < 16; ++r) { p0[r] -= d; p1[r] -= d; }
#pragma unroll
    for (int r = 0; r < 16; ++r) negm[r] = -mhat; }
#pragma unroll
  for (int r = 0; r < 16; ++r) p0[r] = __builtin_amdgcn_exp2f(p0[r]);
}
__device__ __forceinline__ void finishSM(f32x16& p0, f32x16& p1, float alpha, float& l_reg, bf16x8& pa0, bf16x8& pa1, bf16x8& pa2, bf16x8& pa3) {
#pragma unroll
  for (int r = 0; r < 16; ++r) p1[r] = __builtin_amdgcn_exp2f(p1[r]);
  float ps = 0;
#pragma unroll
  for (int r = 0; r < 16; ++r) ps += p0[r];
#pragma unroll
  for (int r = 0; r < 16; ++r) ps += p1[r];
  { auto rr = __builtin_amdgcn_permlane32_swap(__float_as_uint(ps), __float_as_uint(ps), false, false);
    ps = __uint_as_float(rr[0]) + __uint_as_float(rr[1]); }
  l_reg = l_reg * alpha + ps;
#define PK4(P, BASE, OUT) do { unsigned a0 = cvtpk(P[BASE + 0], P[BASE + 1]), a1 = cvtpk(P[BASE + 2], P[BASE + 3]);   \
    unsigned b0 = cvtpk(P[BASE + 4], P[BASE + 5]), b1 = cvtpk(P[BASE + 6], P[BASE + 7]);                              \
    auto r0 = __builtin_amdgcn_permlane32_swap(a0, b0, false, false); auto r1 = __builtin_amdgcn_permlane32_swap(a1, b1, false, false); \
    u32x4 w = {r0[0], r1[0], r0[1], r1[1]}; OUT = *reinterpret_cast<bf16x8*>(&w); } while (0)
  PK4(p0, 0, pa0); PK4(p0, 8, pa1); PK4(p1, 0, pa2); PK4(p1, 8, pa3);
#undef PK4
}
__device__ __forceinline__ void qkt(f32x16& p0, f32x16& p1, const bf16_t* Ks, const bf16x8* qr, const f32x16& negm, int r32, int hi) {
  p0 = negm; p1 = negm;
#pragma unroll
  for (int d0 = 0; d0 < 6; ++d0) { int cb = (d0 * 16 + hi * 8) * 2;
    bf16x8 b0 = *reinterpret_cast<const bf16x8*>((const char*)Ks + KSWZ(r32, cb));
    bf16x8 b1 = *reinterpret_cast<const bf16x8*>((const char*)Ks + KSWZ(32 + r32, cb));
    p0 = __builtin_amdgcn_mfma_f32_32x32x16_bf16(b0, qr[d0], p0, 0, 0, 0);
    p1 = __builtin_amdgcn_mfma_f32_32x32x16_bf16(b1, qr[d0], p1, 0, 0, 0); }
}
__device__ __forceinline__ int v_st(int k, int c) { const int kk = (k & ~0xC) | ((k & 4) << 1) | ((k & 8) >> 1); return ((kk >> 3) * 4 + (c >> 5)) * 512 + ((kk & 7) * 32 + (c & 31)) * 2; }
__device__ __forceinline__ int v_rd_base(int lane) { return ((lane & 3) << 3) | (((lane >> 2) & 3) << 6) | (((lane >> 4) & 1) << 5) | (((lane >> 5) & 1) << 8); }
constexpr int v_rd_off(int d0, int ks, int half) { return d0 * 512 + ks * 4096 + half * 2048; }
template <int OFF> __device__ __forceinline__ s16x4 tr_read(int vb) {
  s16x4 r; asm volatile("ds_read_b64_tr_b16 %0, %1 offset:%2" : "=&v"(r) : "v"(vb), "i"(OFF) : "memory"); return r;
}
template <int D0> __device__ __forceinline__ void pv_one(f32x16& od, int vb, bf16x8 pa0, bf16x8 pa1, bf16x8 pa2, bf16x8 pa3) {
  const s16x4 l0 = tr_read<v_rd_off(D0, 0, 0)>(vb), h0 = tr_read<v_rd_off(D0, 0, 1)>(vb), l1 = tr_read<v_rd_off(D0, 1, 0)>(vb), h1 = tr_read<v_rd_off(D0, 1, 1)>(vb);
  const s16x4 l2 = tr_read<v_rd_off(D0, 2, 0)>(vb), h2 = tr_read<v_rd_off(D0, 2, 1)>(vb), l3 = tr_read<v_rd_off(D0, 3, 0)>(vb), h3 = tr_read<v_rd_off(D0, 3, 1)>(vb);
  asm volatile("s_waitcnt lgkmcnt(0)" ::: "memory"); SBAR();
#define PK(L, H) (bf16x8){L[0], L[1], L[2], L[3], H[0], H[1], H[2], H[3]}
  od = __builtin_amdgcn_mfma_f32_32x32x16_bf16(pa0, PK(l0, h0), od, 0, 0, 0);
  od = __builtin_amdgcn_mfma_f32_32x32x16_bf16(pa1, PK(l1, h1), od, 0, 0, 0);
  od = __builtin_amdgcn_mfma_f32_32x32x16_bf16(pa2, PK(l2, h2), od, 0, 0, 0);
  od = __builtin_amdgcn_mfma_f32_32x32x16_bf16(pa3, PK(l3, h3), od, 0, 0, 0);
#undef PK
}
__device__ __forceinline__ void pv_d0(f32x16* o, int vb, bf16x8 pa0, bf16x8 pa1, bf16x8 pa2, bf16x8 pa3) {
  pv_one<0>(o[0], vb, pa0, pa1, pa2, pa3); pv_one<1>(o[1], vb, pa0, pa1, pa2, pa3);
}
__device__ __forceinline__ void attn_item(const bf16_t* __restrict__ Qb, const bf16_t* __restrict__ Kn, const bf16_t* __restrict__ Kr, const bf16_t* __restrict__ Vh,
                                          const float* __restrict__ csq, bf16_t* __restrict__ Ob, int seq, char* lds) {
  int tid_ = threadIdx.x; asm volatile("" : "+v"(tid_));
  const int tid = tid_, wid = tid >> 6, lane = tid & 63, r32 = lane & 31, hi = lane >> 5;
  bf16_t* V_lds = (bf16_t*)lds; bf16_t* K_lds = (bf16_t*)(lds + 3 * SLOT);
  float* ws = (float*)(lds + 6 * SLOT) + wid * 64; float* li_l = ws; float* al_l = ws + 32;
  float mhat = 0.f, l_reg = 0; f32x16 o[2] = {}; bf16x8 qr[6]; f32x16 negm = f32x16{};
  const bf16_t* Qw = Qb + (long)(wid * QBLK + r32) * 1792 + hi * 8;
#pragma unroll
  for (int d0 = 0; d0 < 6; ++d0) qr[d0] = *reinterpret_cast<const bf16x8*>(Qw + d0 * 16);
  { const float* cp = csq + (long)(wid * QBLK + r32) * 32 + hi * 8;
    const f32x4 c0 = *(const f32x4*)cp, c1 = *(const f32x4*)(cp + 4), s0 = *(const f32x4*)(cp + 16), s1 = *(const f32x4*)(cp + 20);
    float cc[8] = {c0[0], c0[1], c0[2], c0[3], c1[0], c1[1], c1[2], c1[3]}, ss[8] = {s0[0], s0[1], s0[2], s0[3], s1[0], s1[1], s1[2], s1[3]};
    bf16x8 n4, n5;
#pragma unroll
    for (int e = 0; e < 8; ++e) { const float x1 = bf2f((unsigned short)qr[4][e]), x2 = bf2f((unsigned short)qr[5][e]);
      n4[e] = (short)f2bf(x1 * cc[e] - x2 * ss[e]); n5[e] = (short)f2bf(x1 * ss[e] + x2 * cc[e]); }
    qr[4] = n4; qr[5] = n5; }
  const int sr = tid >> 3, sc = (tid & 7) * 8, vst0 = v_st(sr, sc);
  const int rr_ = (tid & 255) >> 2, rc_ = (tid & 3) * 8;
  const int vb0 = (int)(uintptr_t)V_lds + v_rd_base(lane);
  struct { bf16x8 vs, kn, kr; } sr_[1];
#define SLOAD(i, k0) do { sr_[i].vs = *reinterpret_cast<const bf16x8*>(&Vh[(long)((k0) + sr) * 1792 + sc]); sr_[i].kn = *reinterpret_cast<const bf16x8*>(&Kn[(long)((k0) + sr) * 1792 + sc]); \
    sr_[i].kr = *reinterpret_cast<const bf16x8*>(&Kr[(long)((k0) + rr_) * 32 + rc_]); } while (0)
#define SWRITE(off, i) do { *(bf16x8*)((char*)V_lds + (off) + vst0) = sr_[i].vs;          \
    *(bf16x8*)((char*)K_lds + (off) + KSWZ(sr, sc * 2)) = sr_[i].kn;                       \
    if (tid < 256) *(bf16x8*)((char*)K_lds + (off) + KSWZ(rr_, 128 + rc_ * 2)) = sr_[i].kr; } while (0)
#define SWAIT() asm volatile("s_waitcnt vmcnt(0)" ::: "memory")
#define RESC(a) do { if (__any((a) < 1.f)) { if (hi == 0) al_l[r32] = (a); asm volatile("s_waitcnt lgkmcnt(0)" ::: "memory"); \
    _Pragma("unroll") for (int d = 0; d < 2; ++d) _Pragma("unroll") for (int r = 0; r < 16; ++r) o[d][r] *= al_l[crow(r, hi)]; } } while (0)
  f32x16 pA0, pA1, pB0, pB1; float alA, alB; bf16x8 pa0, pa1, pa2, pa3; const int NT = seq / KVBLK;
  int sp = 0, scu = 0, sn = SLOT;
#define ROT() do { sp = scu; scu = sn; sn = (sn == 2 * SLOT) ? 0 : sn + SLOT; } while (0)
#define STEP(PQ0, PQ1, ALQ, PF0, PF1, ALF, T, LOADS) do { \
    SBAR(); qkt(PQ0, PQ1, (bf16_t*)((char*)K_lds + scu), qr, negm, r32, hi); \
    finishSM(PF0, PF1, ALF, l_reg, pa0, pa1, pa2, pa3); SBAR(); \
    if (LOADS) SLOAD(0, ((T) + 1) * KVBLK); SBAR(); \
    pv_d0(o, vb0 + sp, pa0, pa1, pa2, pa3); partialSM<false>(PQ0, PQ1, mhat, negm, ALQ); \
    if (LOADS) { SWAIT(); SWRITE(sn, 0); } \
    RESC(ALQ); __syncthreads(); ROT(); } while (0)
  if (__builtin_amdgcn_readfirstlane(wid) >= 4) __builtin_amdgcn_s_setprio(1);
  __syncthreads();
  SLOAD(0, 0); SWAIT(); SWRITE(0, 0); __syncthreads();
  qkt(pA0, pA1, K_lds, qr, negm, r32, hi); partialSM<true>(pA0, pA1, mhat, negm, alA);
  SLOAD(0, KVBLK); SWAIT(); SWRITE(SLOT, 0); __syncthreads();
  ROT();
  for (int j = 1; j + 1 < NT; j += 2) {
    STEP(pB0, pB1, alB, pA0, pA1, alA, j, true);
    STEP(pA0, pA1, alA, pB0, pB1, alB, j + 1, true);
  }
  STEP(pB0, pB1, alB, pA0, pA1, alA, NT - 1, false);
  finishSM(pB0, pB1, alB, l_reg, pa0, pa1, pa2, pa3); SBAR();
  pv_d0(o, vb0 + sp, pa0, pa1, pa2, pa3);
  __builtin_amdgcn_s_setprio(0);
  if (hi == 0) li_l[r32] = l_reg; asm volatile("s_waitcnt lgkmcnt(0)" ::: "memory");
  float rli[16];
#pragma unroll
  for (int r = 0; r < 16; ++r) rli[r] = __builtin_amdgcn_rcpf(li_l[crow(r, hi)]);
  bf16_t* Ow = Ob + (long)(wid * QBLK) * DM;
#pragma unroll
  for (int r = 0; r < 16; ++r) { int orow = crow(r, hi);
#pragma unroll
    for (int d0 = 0; d0 < 2; ++d0) Ow[(long)orow * DM + d0 * 32 + r32] = (bf16_t)f2bf(o[d0][r] * rli[r]); }
#undef SLOAD
#undef SWRITE
#undef SWAIT
#undef RESC
#undef STEP
#undef ROT
}
}

#ifndef DUP_ATT
#define DUP_ATT 0
#endif
#ifndef DUP_HY
#define DUP_HY 0
#endif
#ifndef DUP_GU
#define DUP_GU 0
#endif
#ifndef DUP_P0
#define DUP_P0 0
#endif
#ifndef PHMASK
#define PHMASK 0xFFFFFFFFu
#endif
template <class Epi> __device__ __forceinline__ void run_gemm(const Ctx& C, const bf16_t* A, const bf16_t* Bt, int N, int K, const Epi E) {
    asm volatile("" : "+s"(K)); asm volatile("" : "+s"(N));
    pg8::Gemm g{A, Bt, MTOK, N, K}; pg8::StaticOrder S; S.init(MTOK, N, C.G, (int)blockIdx.x);
    pg8::gemm_phase<Epi, pg8::StaticOrder, true, true>((PG8_LAS unsigned char*)C.lds, g, S, E);
}
__device__ __forceinline__ ArgsP getargs() { ArgsP p = (ArgsP)__builtin_amdgcn_kernarg_segment_ptr(); asm volatile("" : "+s"(p)); return p; }
__device__ __forceinline__ Ctx mkctx(unsigned char* lds) {
    Ctx C; { int t_ = threadIdx.x; asm volatile("" : "+v"(t_)); C.tid = t_; } C.lane = C.tid & 63; C.wave = __builtin_amdgcn_readfirstlane(C.tid >> 6);
    C.G = gridDim.x; { const int bx = blockIdx.x; C.vcu = (C.G % 8 == 0) ? (bx % 8) * (C.G / 8) + bx / 8 : bx; }
    C.gw = C.vcu * 8 + C.wave; C.NGW = C.G * 8; C.lds = (unsigned char*)(LAS unsigned char*)lds; return C;
}
__global__ void __launch_bounds__(512, 2) mega(Args a_unused) {
    extern __shared__ __attribute__((aligned(16))) unsigned char lds[];
    cg::grid_group grid = cg::this_grid();
    int ph = 0;
    if (threadIdx.x < 2) ((volatile LAS unsigned*)((LAS unsigned char*)lds + (LDS_BYTES - 64)))[threadIdx.x] = 0u;
    __syncthreads();
    { ArgsP a0 = getargs(); unsigned char* ws = (unsigned char*)(GAS unsigned char*)a0->ws; if (threadIdx.x == 0) (void)xb_add(&((unsigned*)(ws + 16384))[XB_XCNT(xb_xcc_id())], 1u); }
#define PH_BEGIN { ArgsP a = getargs(); if (ph >= a->ph_lo && ph < a->ph_hi) { const Ctx C = mkctx(lds); unsigned char* ws = (unsigned char*)(GAS unsigned char*)a->ws; (void)ws; \
    bf16_t* XN = (bf16_t*)(ws + WS_XN); bf16_t* ACT = (bf16_t*)(ws + WS_ACT); bf16_t* Hb = ACT; bf16_t* A2 = (bf16_t*)(ws + WS_A2); bf16_t* UC = (bf16_t*)(ws + WS_UCONV); \
    bf16_t* HYT = (bf16_t*)(ws + WS_HYT); bf16_t* KPE = (bf16_t*)(ws + WS_KPE); const float* CS = (const float*)(ws + WS_ROPE); const float* xin = GIN(a, 0); float* xo = (float*)(GAS float*)a->out; \
    float* RSS = (float*)(ws + WS_RSS); bf16_t* YB = (bf16_t*)xo; (void)RSS; (void)YB; (void)XN; (void)ACT; (void)Hb; (void)A2; (void)UC; (void)HYT; (void)KPE; (void)CS; (void)xin; (void)xo;
#define BAR_WORDS ((unsigned*)(ws + 16384))
#define PH_END if (ph + 1 < a->ph_hi) { \
      if (a->ph_hi < 0) grid.sync();     \
      { XcdBarrier bb; bb.bar = BAR_WORDS; bb.x = xb_xcc_id(); bb.st = (volatile LAS unsigned*)((LAS unsigned char*)lds + (LDS_BYTES - 64)); xcd_barrier(bb); } } } } ++ph;
#define REDL ((PG8_LAS float*)(PG8_LAS unsigned char*)C.lds + 131072 / 4)
#define RSSK(k) (RSS + (size_t)(k) * MTOK * 4)
#define WBL ((const bf16_t*)(ws + WS_W + (size_t)ly * WS_WLAYER))

#define PH_END_NS } }
    PH_BEGIN
        for (int rep = 0; rep <= DUP_P0; ++rep) { if constexpr (PHMASK & 1) p0_weights(C, a); }
    PH_END_NS
    PH_BEGIN
        for (int rep = 0; rep <= DUP_P0; ++rep) { if constexpr (PHMASK & 2) for (int it = C.vcu; it < DEPTH * 128; it += C.G) hyena_filter_item(C, a, it >> 7, it & 127); }
    PH_END_NS
    PH_BEGIN
        if constexpr (PHMASK & 4) cast_rows(C, xin, XN, RSSK(0));
    PH_END

    for (int ly = 0; ly < DEPTH; ++ly) {
        PH_BEGIN
            if constexpr (PHMASK & 8) for (int rep = 0; rep <= DUP_GU; ++rep) run_gemm(C, XN, WBL + WL_GU1, 2 * DFF, DM, pg8::EpiSwiGLU{ACT, DFF, RSSK(3 * ly)});
        PH_END
        PH_BEGIN
            if constexpr (PHMASK & 16) run_gemm(C, ACT, WBL + WL_D1, DM, DFF, pg8::EpiResidualBf{XN, 0.5f, RSSK(3 * ly + 1), REDL});
        PH_END
        PH_BEGIN
            if constexpr (PHMASK & 32) run_gemm(C, XN, WBL + WL_IN, INPAD, DM, pg8::EpiBf16{Hb, INPAD, RSSK(3 * ly + 1)});
        PH_END
        PH_BEGIN
            if constexpr (PHMASK & 64) prep_rows(C, Hb, A2, KPE, UC, CS);
            if constexpr (PHMASK & 128) for (int t = C.vcu; t < MTOK / 64; t += C.G) hy_short_tile(C, Hb, HYT, GIN(a, 16) + ly * 3 * 768, GIN(a, 17) + ly * 768, t);
        PH_END
        PH_BEGIN
            if constexpr (PHMASK & 256) run_gemm(C, A2, WBL + WL_QKV, NQKV, KQKV, pg8::EpiBf16{Hb, NQKV, nullptr});
        PH_END
        PH_BEGIN
            if constexpr (PHMASK & 512) for (int rep = 0; rep <= DUP_ATT; ++rep) for (int it = C.vcu; it < NB * NH * (SEQ / 256); it += C.G) { const int bh = it >> 5, qb = it & 31; const int b = bh >> 3, hh = bh & 7;
                const bf16_t* qkvb = Hb + (size_t)b * SEQ * NQKV;
                att::attn_item(qkvb + (size_t)(qb * 256) * NQKV + hh * 96, qkvb + 768 + hh * 128, KPE + (size_t)b * SEQ * 32, qkvb + 768 + hh * 128 + 64,
                               CS + (size_t)(b * SEQ + qb * 256) * 32, YB + ((size_t)(b * SEQ + qb * 256)) * DM + hh * 64, SEQ, (char*)C.lds); }
        PH_END_NS
        PH_BEGIN
            if constexpr (PHMASK & 1024) for (int t = C.vcu; t < MTOK / 64; t += C.G)
                conv_tile(C, UC, YB, GIN(a, 12) + ly * 31 * 256, GIN(a, 13) + ly * 256, GIN(a, 14) + ly * 256, GIN(a, 15) + ly * 256, t);
        PH_END_NS
        PH_BEGIN
            if constexpr (PHMASK & 2048) for (int rep = 0; rep <= DUP_HY; ++rep) for (int c = C.vcu; c < 256; c += C.G) hyena_item(C, a, ly, c, HYT);
        PH_END
        PH_BEGIN
            if constexpr (PHMASK & 4096) for (int t = C.vcu; t < MTOK / 64; t += C.G) group_norm_tile(C, YB, HYT, t);
        PH_END
        PH_BEGIN
            if constexpr (PHMASK & 16) run_gemm(C, YB, WBL + WL_OUT, DM, DM, pg8::EpiResidualBf{XN, 1.0f, RSSK(3 * ly + 2), REDL});
        PH_END
        PH_BEGIN
            if constexpr (PHMASK & 8) for (int rep = 0; rep <= DUP_GU; ++rep) run_gemm(C, XN, WBL + WL_GU2, 2 * DFF, DM, pg8::EpiSwiGLU{ACT, DFF, RSSK(3 * ly + 2)});
        PH_END
        PH_BEGIN
            if constexpr (PHMASK & 16) run_gemm(C, ACT, WBL + WL_D2, DM, DFF, pg8::EpiResidualBf{XN, 0.5f, RSSK(3 * ly + 3), REDL});
        PH_END
    }
    PH_BEGIN
        if constexpr (PHMASK & 8192) final_norm_rows(C, XN, RSSK(3 * DEPTH), xo, GIN(a, 33));
    PH_END
}
constexpr int N_PHASES = 1 + DEPTH * 10 + 1;

extern "C" void kernel_launch(void* const* d_in, const int* in_sizes, int n_in, void* d_out, int out_size, void* d_ws, size_t ws_size, hipStream_t stream) {
    static int grid = 0;
    if (grid == 0) {
        if (n_in != 34 || in_sizes[0] != MTOK * DM || out_size != MTOK * DM || ws_size < WS_END) {
            fprintf(stderr, "kernel_launch: shape/workspace mismatch: n_in %d in0 %d out %d ws %zu (need %zu)\n", n_in, n_in > 0 ? in_sizes[0] : -1, out_size, ws_size, (size_t)WS_END); grid = -1; return; }
        int dev = 0, cus = 0, per = 0;
        (void)hipGetDevice(&dev);
        (void)hipDeviceGetAttribute(&cus, hipDeviceAttributeMultiprocessorCount, dev);
        if (hipFuncSetAttribute((const void*)mega, hipFuncAttributeMaxDynamicSharedMemorySize, LDS_BYTES) != hipSuccess) { fprintf(stderr, "kernel_launch: hipFuncSetAttribute failed\n"); grid = -1; return; }
        (void)hipOccupancyMaxActiveBlocksPerMultiprocessor(&per, (const void*)mega, 512, LDS_BYTES);
        if (per < 1) per = 1;
        grid = cus * per;
        fprintf(stderr, "kernel_launch: grid %d (cus %d x %d), ws %zu\n", grid, cus, per, ws_size);
    }
    if (grid < 0) return;
    if (hipMemsetAsync((char*)d_ws + 16384, 0, XCD_BAR_WORDS * 4, stream) != hipSuccess) { fprintf(stderr, "kernel_launch: memset of barrier words failed\n"); return; }
    Args a{};
    for (int i = 0; i < 34; ++i) a.in[i] = d_in[i];
    a.out = (float*)d_out; a.ws = (unsigned char*)d_ws; a.ph_lo = 0; a.ph_hi = N_PHASES;
    void* args[] = {&a};
    hipError_t e = hipLaunchCooperativeKernel((const void*)mega, dim3(grid), dim3(512), args, LDS_BYTES, stream);
    if (e != hipSuccess) fprintf(stderr, "kernel_launch: cooperative launch failed: %s (grid %d)\n", hipGetErrorString(e), grid);
}
```

```cpp
#include <hip/hip_runtime.h>
#include <hip/hip_cooperative_groups.h>
#include <hip/hip_bf16.h>
#include <cstdio>
#include <cstdint>
namespace cg = cooperative_groups;
namespace pg8 {
#define PG8_LAS __attribute__((address_space(3)))
typedef unsigned short bf16_t;
typedef short bf16x8 __attribute__((ext_vector_type(8)));
typedef float f32x4 __attribute__((ext_vector_type(4)));
typedef unsigned u32x4 __attribute__((ext_vector_type(4)));
constexpr int BM = 256, BK = 64, HALF = 128, HTB = HALF * BK * 2  , STAGE_BYTES = 8 * HTB, NXCD = 8, WGM = 8;

__host__ __device__ __forceinline__ int lds_byte(int r, int c) { const int st = (r >> 4) * 2 + (c >> 5), rr = r & 15, cc = c & 31, ob = rr * 64 + cc * 2; return st * 1024 + (ob ^ (((ob >> 9) & 1) << 5)); }
__host__ __device__ __forceinline__ void stage_rc(int b, int& R, int& C) { const int st = b / 1024, sb = b % 1024, swz = sb ^ (((sb >> 9) & 1) << 5); R = (st >> 1) * 16 + swz / 64; C = (st & 1) * 32 + (swz % 64) / 2; }
__host__ __device__ __forceinline__ int perm32(int rho) { const int n = rho >> 4, i = rho & 15; return 8 * (i >> 2) + 4 * n + (i & 3); }

struct Unit { int pm, pn; };
struct Gemm { const bf16_t* A; const bf16_t* Bt; int M, N, K; };

struct StaticOrder {
    int nM, nN, nwg, G, c;
    __host__ __device__ void init(int M, int N, int G_, int c_) { nM = M / BM; nN = N / BM; nwg = nM * nN; G = G_; c = c_; }
    __host__ __device__ bool next(int i, Unit& u) const {
        const long L = (long)i * G + c; if (L >= nwg) return false;
        int wgid = (int)L; { const int q = nwg / NXCD, r = nwg % NXCD, xcd = wgid % NXCD, off = wgid / NXCD; wgid = (xcd < r ? xcd * (q + 1) : r * (q + 1) + (xcd - r) * q) + off; }
        const int nig = WGM * nN, gid = wgid / nig, fm = gid * WGM, gsz = (nM - fm) < WGM ? (nM - fm) : WGM;
        u.pm = fm + ((wgid % nig) % gsz); u.pn = (wgid % nig) / gsz; return true;
    }
    __device__ __forceinline__ void a_ready(const Unit&) const {}
    __device__ __forceinline__ void done(const Unit&) const {}
};

__device__ __forceinline__ unsigned cvt_pk_bf16(float lo, float hi) { unsigned r; asm volatile("v_cvt_pk_bf16_f32 %0, %1, %2" : "=v"(r) : "v"(lo), "v"(hi)); return r; }
typedef float f32x2 __attribute__((ext_vector_type(2)));
__device__ __forceinline__ float silu_f(float g) { return g * __builtin_amdgcn_rcpf(1.0f + __expf(-g)); }
__device__ __forceinline__ float row_rstd(const float* rss, int row) { if (!rss) return 1.0f; const f32x4 s = *(const f32x4*)(rss + 4 * (size_t)row); return __builtin_amdgcn_rsqf(((s[0] + s[1]) + (s[2] + s[3])) * (1.0f / 1024.0f) + 1e-6f); }
struct EpiBf16 {
    static constexpr bool PERM = true, AFTER_DRAIN = false;
    bf16_t* O; int ldc; const float* rss;
    __device__ __forceinline__ void operator()(const f32x4 (&acc)[2][2][4][2], const Unit& u, int wr, int wc, int fr, int fq) const {
        const int row0 = u.pm * BM + wr * 64 + fr; const int col0 = u.pn * BM + wc * 32 + 8 * fq;
#pragma unroll
        for (int ai = 0; ai < 2; ++ai)
#pragma unroll
            for (int m = 0; m < 4; ++m) { const int row = row0 + ai * HALF + m * 16; bf16_t* rowp = O + (size_t)row * ldc + col0; const float rs = row_rstd(rss, row);
#pragma unroll
                for (int bj = 0; bj < 2; ++bj) { const f32x4 v0 = acc[ai][bj][m][0] * rs, v1 = acc[ai][bj][m][1] * rs;
                    u32x4 w; w.x = cvt_pk_bf16(v0[0], v0[1]); w.y = cvt_pk_bf16(v0[2], v0[3]); w.z = cvt_pk_bf16(v1[0], v1[1]); w.w = cvt_pk_bf16(v1[2], v1[3]);
                    *(u32x4*)(rowp + bj * HALF) = w; } }
    }
};
struct EpiSwiGLU {
    static constexpr bool PERM = true, AFTER_DRAIN = false;
    bf16_t* O; int ldc; const float* rss;
    __device__ __forceinline__ void operator()(const f32x4 (&acc)[2][2][4][2], const Unit& u, int wr, int wc, int fr, int fq) const {
        const int row0 = u.pm * BM + wr * 64 + fr; const int col0 = u.pn * HALF + wc * 32 + 8 * fq;
#pragma unroll
        for (int ai = 0; ai < 2; ++ai)
#pragma unroll
            for (int m = 0; m < 4; ++m) { const int row = row0 + ai * HALF + m * 16; bf16_t* rowp = O + (size_t)row * ldc + col0; const float rs = row_rstd(rss, row);
                const f32x4 g0 = acc[ai][0][m][0] * rs, g1 = acc[ai][0][m][1] * rs, u0 = acc[ai][1][m][0] * rs, u1 = acc[ai][1][m][1] * rs;
                u32x4 w;
                w.x = cvt_pk_bf16(silu_f(g0[0]) * u0[0], silu_f(g0[1]) * u0[1]); w.y = cvt_pk_bf16(silu_f(g0[2]) * u0[2], silu_f(g0[3]) * u0[3]);
                w.z = cvt_pk_bf16(silu_f(g1[0]) * u1[0], silu_f(g1[1]) * u1[1]); w.w = cvt_pk_bf16(silu_f(g1[2]) * u1[2], silu_f(g1[3]) * u1[3]);
                *(u32x4*)rowp = w; }
    }
};
struct EpiResidualBf {
    static constexpr bool PERM = true, AFTER_DRAIN = false;
    bf16_t* x; float scale; float* rss; PG8_LAS float* red;
    __device__ __forceinline__ void operator()(const f32x4 (&acc)[2][2][4][2], const Unit& u, int wr, int wc, int fr, int fq) const {
        const int row0 = u.pm * BM + wr * 64 + fr; const int col0 = u.pn * BM + wc * 32 + 8 * fq;
#pragma unroll
        for (int ai = 0; ai < 2; ++ai)
#pragma unroll
            for (int m = 0; m < 4; ++m) { const int row = row0 + ai * HALF + m * 16; bf16_t* rowp = x + (size_t)row * 1024 + col0; float ss = 0.f;
                const u32x4 b0 = *(const u32x4*)rowp, b1 = *(const u32x4*)(rowp + HALF);
#pragma unroll
                for (int bj = 0; bj < 2; ++bj) { const u32x4 bb = bj ? b1 : b0; const f32x4 a0 = acc[ai][bj][m][0], a1 = acc[ai][bj][m][1];
                    float v[8];
                    v[0] = __builtin_bit_cast(float, bb.x << 16) + scale * a0[0]; v[1] = __builtin_bit_cast(float, bb.x & 0xffff0000u) + scale * a0[1];
                    v[2] = __builtin_bit_cast(float, bb.y << 16) + scale * a0[2]; v[3] = __builtin_bit_cast(float, bb.y & 0xffff0000u) + scale * a0[3];
                    v[4] = __builtin_bit_cast(float, bb.z << 16) + scale * a1[0]; v[5] = __builtin_bit_cast(float, bb.z & 0xffff0000u) + scale * a1[1];
                    v[6] = __builtin_bit_cast(float, bb.w << 16) + scale * a1[2]; v[7] = __builtin_bit_cast(float, bb.w & 0xffff0000u) + scale * a1[3];
                    ss += ((v[0] * v[0] + v[1] * v[1]) + (v[2] * v[2] + v[3] * v[3])) + ((v[4] * v[4] + v[5] * v[5]) + (v[6] * v[6] + v[7] * v[7]));
                    u32x4 w; w.x = cvt_pk_bf16(v[0], v[1]); w.y = cvt_pk_bf16(v[2], v[3]); w.z = cvt_pk_bf16(v[4], v[5]); w.w = cvt_pk_bf16(v[6], v[7]);
                    *(u32x4*)(rowp + bj * HALF) = w; }
                ss += __shfl_xor(ss, 16); ss += __shfl_xor(ss, 32);
                if (fq == 0) red[(ai * HALF + wr * 64 + m * 16 + fr) * 4 + wc] = ss;
                asm volatile("" ::: "memory"); }
        asm volatile("s_waitcnt lgkmcnt(0)" ::: "memory"); __builtin_amdgcn_s_barrier(); asm volatile("" ::: "memory");
        { const int t = threadIdx.x; if (t < 256) { const f32x4 p = *(const PG8_LAS f32x4*)(red + 4 * t); rss[4 * (size_t)(u.pm * BM + t) + u.pn] = (p[0] + p[1]) + (p[2] + p[3]); } }
        asm volatile("s_waitcnt lgkmcnt(0)" ::: "memory"); __builtin_amdgcn_s_barrier(); asm volatile("" ::: "memory");
    }
};
template <class Epi, class Sched, bool ALIGN_EPI = false, bool SP2 = false>
__device__ __forceinline__ void gemm_phase(PG8_LAS unsigned char* lds, const Gemm g, const Sched& S, const Epi& E) {
    int tid_ = threadIdx.x; asm volatile("" : "+v"(tid_));
    const int tid = tid_, wid = __builtin_amdgcn_readfirstlane(tid >> 6), lane = tid & 63, wr = wid >> 2, wc = wid & 3, fr = lane & 15, fq = lane >> 4;
    const int K = g.K, nt = K / BK;
    unsigned voffA[2], voffB[2];
#pragma unroll
    for (int i = 0; i < 2; ++i) { int R, C; stage_rc(tid * 16 + i * 8192, R, C); const int Rb = Epi::PERM ? ((R & ~31) + perm32(R & 31)) : R;
        voffA[i] = (unsigned)(R * K + C) * 2u; voffB[i] = (unsigned)(Rb * K + C) * 2u; }
    const size_t kstep = (size_t)(BK * 2);
    const size_t hstep = (size_t)HALF * K * 2;
    const size_t tstep = 2 * hstep;
    const unsigned ldsw = (unsigned)wid * 1024u;
    const int aoff = lds_byte(wr * 64 + fr, fq * 8), boff = lds_byte(wc * 32 + fr, fq * 8);
#define PG8_SA(b, h) (((b) * 2 + (h)) * HTB)
#define PG8_SB(b, h) ((4 + (b) * 2 + (h)) * HTB)
#define PG8_STAGE(bufoff, gbase, voff) do { _Pragma("unroll") for (int _i = 0; _i < 2; ++_i) \
        __builtin_amdgcn_global_load_lds((const unsigned*)((const char*)(gbase) + (voff)[_i]), (PG8_LAS unsigned*)(lds + (bufoff) + ldsw + _i * 8192), 16, 0, 0); } while (0)
#define PG8_LDA(dst, b, h) do { _Pragma("unroll") for (int m = 0; m < 4; ++m) _Pragma("unroll") for (int k = 0; k < 2; ++k) dst[m][k] = *(const PG8_LAS bf16x8*)(lds + PG8_SA(b, h) + aoff + m * 2048 + k * 1024); } while (0)
#define PG8_LDB(dst, b, h) do { _Pragma("unroll") for (int n = 0; n < 2; ++n) _Pragma("unroll") for (int k = 0; k < 2; ++k) dst[n][k] = *(const PG8_LAS bf16x8*)(lds + PG8_SB(b, h) + boff + n * 2048 + k * 1024); } while (0)
#define PG8_MMA(ai, bj, At, Bt) do { __builtin_amdgcn_s_setprio(1); _Pragma("unroll") for (int m = 0; m < 4; ++m) _Pragma("unroll") for (int n = 0; n < 2; ++n) _Pragma("unroll") for (int k = 0; k < 2; ++k) \
        acc[ai][bj][m][n] = __builtin_amdgcn_mfma_f32_16x16x32_bf16(Bt[n][k], At[m][k], acc[ai][bj][m][n], 0, 0, 0); __builtin_amdgcn_s_setprio(0); } while (0)
#define PG8_WAIT_V(n) asm volatile("s_waitcnt vmcnt(" #n ")" ::: "memory")
#define PG8_WAIT_L(n) asm volatile("s_waitcnt lgkmcnt(" #n ")" ::: "memory")
#define PG8_BAR __builtin_amdgcn_s_barrier()
#define PG8_SCHED __builtin_amdgcn_sched_barrier(0)
    Unit cur, nxt; int ui = 0;
    if (!S.next(0, cur)) return;
    f32x4 acc[2][2][4][2];
#pragma unroll
    for (int a = 0; a < 2; ++a)
#pragma unroll
        for (int b = 0; b < 2; ++b)
#pragma unroll
            for (int m = 0; m < 4; ++m)
#pragma unroll
                for (int n = 0; n < 2; ++n) acc[a][b][m][n] = (f32x4){0.f, 0.f, 0.f, 0.f};
    bf16x8 At[4][2], B0[2][2], B1[2][2];
    const char* cA = (const char*)g.A + (size_t)cur.pm * tstep; const char* cB = (const char*)g.Bt + (size_t)cur.pn * tstep;
    S.a_ready(cur);
    if constexpr (SP2) {
        PG8_STAGE(PG8_SB(0, 0), cB, voffB); PG8_STAGE(PG8_SB(0, 1), cB + hstep, voffB); PG8_STAGE(PG8_SA(0, 0), cA, voffA); PG8_STAGE(PG8_SA(0, 1), cA + hstep, voffA);
        if (wr == 1) PG8_BAR;
        PG8_WAIT_V(2); PG8_BAR;
        PG8_STAGE(PG8_SB(1, 0), cB + kstep, voffB); PG8_STAGE(PG8_SA(1, 0), cA + kstep, voffA); PG8_STAGE(PG8_SB(1, 1), cB + hstep + kstep, voffB);
        PG8_WAIT_V(6); PG8_BAR;
    } else {
        PG8_STAGE(PG8_SB(0, 0), cB, voffB); PG8_STAGE(PG8_SA(0, 0), cA, voffA); PG8_STAGE(PG8_SB(0, 1), cB + hstep, voffB); PG8_STAGE(PG8_SA(0, 1), cA + hstep, voffA);
        if (wr == 1) PG8_BAR;
        PG8_WAIT_V(4); PG8_BAR;
        PG8_STAGE(PG8_SB(1, 0), cB + kstep, voffB); PG8_STAGE(PG8_SA(1, 0), cA + kstep, voffA); PG8_STAGE(PG8_SB(1, 1), cB + hstep + kstep, voffB);
        PG8_WAIT_V(6); PG8_BAR;
    }
    for (;;) {
        const bool has_next = S.next(ui + 1, nxt);
        const char* nA = has_next ? (const char*)g.A + (size_t)nxt.pm * tstep : cA; const char* nB = has_next ? (const char*)g.Bt + (size_t)nxt.pn * tstep : cB;
        for (int t = 0; t < nt; t += 2) {
            const bool last = (t == nt - 2);
            const char* a1 = cA + (size_t)(t + 1) * kstep;
            const char* a2 = last ? nA : cA + (size_t)(t + 2) * kstep; const char* b2 = last ? nB : cB + (size_t)(t + 2) * kstep;
            const char* a3 = a2 + kstep; const char* b3 = b2 + kstep;
            if (last && has_next) S.a_ready(nxt);
            if constexpr (SP2) {
            PG8_LDB(B0, 0, 0); PG8_LDB(B1, 0, 1); PG8_SCHED; PG8_LDA(At, 0, 0); PG8_STAGE(PG8_SA(1, 1), a1 + hstep, voffA);
            PG8_WAIT_V(8); PG8_WAIT_L(0); PG8_BAR; PG8_MMA(0, 0, At, B0); PG8_MMA(0, 1, At, B1); PG8_BAR; PG8_SCHED;
            PG8_LDA(At, 0, 1); PG8_STAGE(PG8_SB(0, 0), b2, voffB); PG8_STAGE(PG8_SB(0, 1), b2 + hstep, voffB); PG8_STAGE(PG8_SA(0, 0), a2, voffA);
            PG8_WAIT_V(8); PG8_WAIT_L(0); PG8_BAR; PG8_MMA(1, 0, At, B0); PG8_MMA(1, 1, At, B1); PG8_BAR; PG8_SCHED;
            PG8_LDB(B0, 1, 0); PG8_LDB(B1, 1, 1); PG8_SCHED; PG8_LDA(At, 1, 0); PG8_STAGE(PG8_SA(0, 1), a2 + hstep, voffA);
            PG8_WAIT_V(8); PG8_WAIT_L(0); PG8_BAR; PG8_MMA(0, 0, At, B0); PG8_MMA(0, 1, At, B1); PG8_BAR; PG8_SCHED;
            PG8_LDA(At, 1, 1); PG8_STAGE(PG8_SB(1, 0), b3, voffB); PG8_STAGE(PG8_SB(1, 1), b3 + hstep, voffB); PG8_STAGE(PG8_SA(1, 0), a3, voffA);
            PG8_WAIT_V(8); PG8_WAIT_L(0); PG8_BAR; PG8_MMA(1, 0, At, B0); PG8_MMA(1, 1, At, B1); PG8_BAR; PG8_SCHED;
            } else {
            PG8_LDB(B0, 0, 0); PG8_SCHED; PG8_LDA(At, 0, 0); PG8_STAGE(PG8_SA(1, 1), a1 + hstep, voffA);
            PG8_WAIT_L(8); PG8_BAR; PG8_WAIT_L(0); PG8_MMA(0, 0, At, B0); PG8_BAR; PG8_SCHED;
            PG8_LDB(B1, 0, 1); PG8_STAGE(PG8_SB(0, 0), b2, voffB);
            PG8_BAR; PG8_WAIT_L(0); PG8_MMA(0, 1, At, B1); PG8_BAR;
            PG8_LDA(At, 0, 1); PG8_STAGE(PG8_SA(0, 0), a2, voffA);
            PG8_BAR; PG8_WAIT_L(0); PG8_MMA(1, 0, At, B0); PG8_BAR; PG8_SCHED;
            PG8_STAGE(PG8_SB(0, 1), b2 + hstep, voffB);
            PG8_WAIT_V(6); PG8_BAR; PG8_MMA(1, 1, At, B1); PG8_BAR;
            PG8_LDB(B0, 1, 0); PG8_SCHED; PG8_LDA(At, 1, 0); PG8_STAGE(PG8_SA(0, 1), a2 + hstep, voffA);
            PG8_WAIT_L(8); PG8_BAR; PG8_WAIT_L(0); PG8_MMA(0, 0, At, B0); PG8_BAR; PG8_SCHED;
            PG8_LDB(B1, 1, 1); PG8_STAGE(PG8_SB(1, 0), b3, voffB);
            PG8_BAR; PG8_WAIT_L(0); PG8_MMA(0, 1, At, B1); PG8_BAR;
            PG8_LDA(At, 1, 1); PG8_STAGE(PG8_SA(1, 0), a3, voffA);
            PG8_BAR; PG8_WAIT_L(0); PG8_MMA(1, 0, At, B0); PG8_BAR; PG8_SCHED;
            PG8_STAGE(PG8_SB(1, 1), b3 + hstep, voffB);
            PG8_WAIT_V(6); PG8_BAR; PG8_MMA(1, 1, At, B1); PG8_BAR;
            }
        }
        if constexpr (ALIGN_EPI) { if (wr == 0) PG8_BAR; }
        if constexpr (!Epi::AFTER_DRAIN) { E(acc, cur, wr, wc, fr, fq); S.done(cur); }
        if (!has_next) break;
#pragma unroll
        for (int a = 0; a < 2; ++a)
#pragma unroll
            for (int b = 0; b < 2; ++b)
#pragma unroll
                for (int m = 0; m < 4; ++m)
#pragma unroll
                    for (int n = 0; n < 2; ++n) acc[a][b][m][n] = (f32x4){0.f, 0.f, 0.f, 0.f};
        cur = nxt; cA = nA; cB = nB; ++ui;
        if constexpr (ALIGN_EPI) { if (wr == 1) PG8_BAR; }
    }
    PG8_WAIT_V(0);
    if constexpr (!ALIGN_EPI) { if (wr == 0) PG8_BAR; }
    PG8_BAR;
    if constexpr (Epi::AFTER_DRAIN) { E.fused(acc, cur, wr, wc, fr, fq, lds, wid, lane); S.done(cur); }
#undef PG8_SA
#undef PG8_SB
#undef PG8_STAGE
#undef PG8_LDA
#undef PG8_LDB
#undef PG8_MMA
#undef PG8_WAIT_V
#undef PG8_WAIT_L
#undef PG8_BAR
#undef PG8_SCHED
}
}
typedef unsigned short bf16_t;
typedef short bf16x8 __attribute__((ext_vector_type(8)));
typedef short s16x4 __attribute__((ext_vector_type(4)));
typedef float f32x4 __attribute__((ext_vector_type(4)));
typedef float f32x16 __attribute__((ext_vector_type(16)));
typedef unsigned u32x4 __attribute__((ext_vector_type(4)));
typedef unsigned u32x2 __attribute__((ext_vector_type(2)));
constexpr int DM = 1024, NB = 4, SEQ = 8192, MTOK = NB * SEQ, DEPTH = 2, DFF = 2816;
constexpr int NH = 8, QKD = 96, VD = 64, INPAD = 1792, NQKV = 1792, KQKV = 384;
constexpr int OFF_KPE = 384, OFF_CONV = 416, OFF_HY = 928;
constexpr float EPS = 1e-6f;
constexpr size_t MiB = 1u << 20;
constexpr size_t WL_GU1 = 0, WL_D1 = WL_GU1 + (size_t)2 * DFF * DM, WL_IN = WL_D1 + (size_t)DM * DFF, WL_QKV = WL_IN + (size_t)INPAD * DM,
                 WL_OUT = WL_QKV + (size_t)NQKV * KQKV, WL_GU2 = WL_OUT + (size_t)DM * DM, WL_D2 = WL_GU2 + (size_t)2 * DFF * DM, WL_END = WL_D2 + (size_t)DM * DFF;
static_assert(WL_END * 2 <= 40 * MiB, "weights per layer");
constexpr size_t WS_RSS = 480 * MiB, WS_W = 1 * MiB, WS_WLAYER = 40 * MiB, WS_ROPE = 81 * MiB, WS_PSUM = 85 * MiB, WS_KK = 86 * MiB, WS_XN = 150 * MiB, WS_ACT = 214 * MiB,
                 WS_Q = WS_ACT, WS_KN = WS_ACT + 48 * MiB, WS_V = WS_ACT + 80 * MiB, WS_A2 = 390 * MiB, WS_UCONV = 414 * MiB, WS_HYT = 430 * MiB, WS_KPE = 478 * MiB, WS_END = 484 * MiB;
constexpr int LDS_BYTES = 150 * 1024;

__device__ __forceinline__ unsigned f2bf(float f) { unsigned u = __builtin_bit_cast(unsigned, f); return (u + 0x7fffu + ((u >> 16) & 1u)) >> 16; }
__device__ __forceinline__ unsigned pk2(float lo, float hi) { return f2bf(lo) | (f2bf(hi) << 16); }
__device__ __forceinline__ float bf2f(unsigned h) { return __builtin_bit_cast(float, h << 16); }
__device__ __forceinline__ float bflo(unsigned w) { return __builtin_bit_cast(float, w << 16); }
__device__ __forceinline__ float bfhi(unsigned w) { return __builtin_bit_cast(float, w & 0xffff0000u); }
__device__ __forceinline__ float wave_sum(float v) {
#pragma unroll
    for (int o = 1; o < 64; o <<= 1) v += __shfl_xor(v, o);
    return v;
}
#define LDS_WAIT() asm volatile("s_waitcnt lgkmcnt(0)" ::: "memory")

#define GAS __attribute__((address_space(1)))
#define LAS __attribute__((address_space(3)))
#define GIN(a, k) ((const float*)(GAS const float*)(a)->in[k])
struct Args { const void* in[34]; float* out; unsigned char* ws; int ph_lo, ph_hi; };
typedef const __attribute__((address_space(4))) Args* ArgsP;
struct Ctx { int tid, lane, wave, G, vcu, gw, NGW; unsigned char* lds; };

__device__ __forceinline__ void tr_matrix(const Ctx& C, const float* W, int K, int N, bf16_t* WT, int ldk, int koff, const float* gain, int mode, int row_off, float gs = 1.0f) {
    float* scr = (float*)(C.lds + C.wave * 8704);
    const int nblk = N / 32, nitems = (K / 64) * nblk, lane = C.lane;
    for (int item = C.gw; item < nitems; item += C.NGW) {
        const int kb = item / nblk, nb = item % nblk, k0 = 64 * kb, n0 = 32 * nb;
        { float tv[32]; const float* wp = W + (size_t)(k0 + (lane >> 5)) * N + n0 + (lane & 31);
#pragma unroll
          for (int i = 0; i < 32; ++i) tv[i] = wp[(size_t)(2 * i) * N];
#pragma unroll
          for (int i = 0; i < 32; ++i) scr[(2 * i + (lane >> 5)) * 33 + (lane & 31)] = tv[i]; }
        LDS_WAIT(); asm volatile("" ::: "memory");
        const int c = lane & 7;
        float g[8];
#pragma unroll
        for (int e = 0; e < 8; ++e) g[e] = gain ? gain[k0 + 8 * c + e] * gs : 1.0f;
        const int drow0 = (mode == 0) ? (row_off + n0) : (256 * (n0 >> 7) + (n0 & 127) + row_off);
#pragma unroll
        for (int j = 0; j < 4; ++j) { const int n = (lane >> 3) + 8 * j; const float* s = scr + (8 * c) * 33 + n;
            u32x4 o; o.x = pk2(s[0 * 33] * g[0], s[1 * 33] * g[1]); o.y = pk2(s[2 * 33] * g[2], s[3 * 33] * g[3]); o.z = pk2(s[4 * 33] * g[4], s[5 * 33] * g[5]); o.w = pk2(s[6 * 33] * g[6], s[7 * 33] * g[7]);
            *(u32x4*)(WT + (size_t)(drow0 + n) * ldk + koff + k0 + 8 * c) = o; }
        LDS_WAIT(); asm volatile("" ::: "memory");
    }
}
__device__ __forceinline__ void p0_weights(const Ctx& C, ArgsP a) {
    for (int ly = 0; ly < DEPTH; ++ly) {
        bf16_t* WB = (bf16_t*)((unsigned char*)(GAS unsigned char*)a->ws + WS_W + (size_t)ly * WS_WLAYER);
        const float* n1 = GIN(a, 2) + ly * DM; const float* nm = GIN(a, 6) + ly * DM; const float* n2 = GIN(a, 29) + ly * DM;
        tr_matrix(C, GIN(a, 3) + (size_t)ly * DM * DFF, DM, DFF, WB + WL_GU1, DM, 0, n1, 1, 0);
        tr_matrix(C, GIN(a, 4) + (size_t)ly * DM * DFF, DM, DFF, WB + WL_GU1, DM, 0, n1, 1, 128);
        tr_matrix(C, GIN(a, 5) + (size_t)ly * DFF * DM, DFF, DM, WB + WL_D1, DFF, 0, nullptr, 0, 0);
        tr_matrix(C, GIN(a, 7) + (size_t)ly * DM * 1696, DM, 1696, WB + WL_IN, DM, 0, nm, 0, 0);
        tr_matrix(C, GIN(a, 9) + (size_t)ly * 256 * 768, 256, 768, WB + WL_QKV, KQKV, 0, GIN(a, 8) + ly * 256, 0, 0, 0.10206207261596575f * 1.4426950408889634f);
        tr_matrix(C, GIN(a, 11) + (size_t)ly * 128 * 1024, 128, 1024, WB + WL_QKV, KQKV, 256, GIN(a, 10) + ly * 128, 0, 768);
        tr_matrix(C, GIN(a, 28) + (size_t)ly * DM * DM, DM, DM, WB + WL_OUT, DM, 0, GIN(a, 27) + ly * DM, 0, 0);
        tr_matrix(C, GIN(a, 30) + (size_t)ly * DM * DFF, DM, DFF, WB + WL_GU2, DM, 0, n2, 1, 0);
        tr_matrix(C, GIN(a, 31) + (size_t)ly * DM * DFF, DM, DFF, WB + WL_GU2, DM, 0, n2, 1, 128);
        tr_matrix(C, GIN(a, 32) + (size_t)ly * DFF * DM, DFF, DM, WB + WL_D2, DFF, 0, nullptr, 0, 0);
        const int gt = C.vcu * 512 + C.tid, GT = C.G * 512;
        for (int i = gt; i < 96 * DM / 8; i += GT) *(u32x4*)(WB + WL_IN + (size_t)1696 * DM + (size_t)i * 8) = (u32x4){0u, 0u, 0u, 0u};
        for (int i = gt; i < 768 * 16; i += GT) { const int r = i >> 4, cc = i & 15; *(u32x4*)(WB + WL_QKV + (size_t)r * KQKV + 256 + cc * 8) = (u32x4){0u, 0u, 0u, 0u}; }
        for (int i = gt; i < 1024 * 32; i += GT) { const int r = 768 + (i >> 5), cc = i & 31; *(u32x4*)(WB + WL_QKV + (size_t)r * KQKV + cc * 8) = (u32x4){0u, 0u, 0u, 0u}; }
    }
    { float* cs = (float*)((unsigned char*)(GAS unsigned char*)a->ws + WS_ROPE); const int* pos = (const int*)(GAS const int*)a->in[1];
      const int gt = C.vcu * 512 + C.tid, GT = C.G * 512;
      for (int idx = gt; idx < MTOK * 16; idx += GT) { const int row = idx >> 4, i = idx & 15;
          double f = 1.0; for (int e = 0; e < i; ++e) f *= 0.5623413251903491;
          const double rev = (double)pos[row] * f * 0.15915494309189535; const float fr = (float)(rev - __builtin_rint(rev));
          cs[(size_t)row * 32 + i] = __builtin_amdgcn_cosf(fr); cs[(size_t)row * 32 + 16 + i] = __builtin_amdgcn_sinf(fr); } }
}
__device__ __forceinline__ float sin_rev(float x) { return __builtin_amdgcn_sinf(x * 0.15915494309189535f); }
__device__ __forceinline__ void hyena_filter_item(const Ctx& C, ArgsP a, int ly, int ch) {
    float* zf = (float*)C.lds;
    float* hA = zf + 64 * 36;
    float* hB = hA + 64 * 68;
    float* ps = hB + 64 * 68;
    const int tid = C.tid; const int l0 = ch * 64;
    const float* w1 = GIN(a, 18) + ly * 33 * 64; const float* b1 = GIN(a, 19) + ly * 64;
    const float* w2 = GIN(a, 20) + ly * 64 * 64; const float* b2 = GIN(a, 21) + ly * 64;
    const float* w3 = GIN(a, 22) + ly * 64 * 64; const float* b3 = GIN(a, 23) + ly * 64;
    const float* w4 = GIN(a, 24) + (size_t)ly * 64 * 1024; const float* frq = GIN(a, 25) + ly * 64;
    __syncthreads();
    for (int idx = tid; idx < 64 * 36; idx += 512) { const int p = idx / 36, f = idx - 36 * p; const int l = l0 + p; float v;
        if (f >= 33) v = 0.f;
        else if (f == 0) v = (float)l / 8191.0f;
        else { const int bi = (f - 1) & 15; const float fb = 1e-4f + (float)bi * ((15.0f - 1e-4f) / 15.0f); const float rev = fb * ((float)l / 8192.0f);
            v = (f <= 16) ? __builtin_amdgcn_cosf(rev) : -__builtin_amdgcn_sinf(rev); }
        zf[p * 36 + f] = v; }
    __syncthreads();
    { const int u = tid & 63; const float fr = frq[u], bb = b1[u]; float wr_[36];
#pragma unroll
      for (int f = 0; f < 36; ++f) wr_[f] = (f < 33) ? w1[f * 64 + u] : 0.f;
#pragma unroll 1
      for (int p = tid >> 6; p < 64; p += 8) { float s = bb;
#pragma unroll
          for (int f4 = 0; f4 < 9; ++f4) { const f32x4 z = *(const f32x4*)(zf + p * 36 + 4 * f4); s += z[0] * wr_[4 * f4] + z[1] * wr_[4 * f4 + 1] + z[2] * wr_[4 * f4 + 2] + z[3] * wr_[4 * f4 + 3]; }
          hA[p * 68 + u] = sin_rev(fr * s); } }
    __syncthreads();
    { const int u = tid & 63; const float fr = frq[u], bb = b2[u]; float wr_[64];
#pragma unroll
      for (int f = 0; f < 64; ++f) wr_[f] = w2[f * 64 + u];
#pragma unroll 1
      for (int p = tid >> 6; p < 64; p += 8) { float s = bb;
#pragma unroll
          for (int f4 = 0; f4 < 16; ++f4) { const f32x4 z = *(const f32x4*)(hA + p * 68 + 4 * f4); s += z[0] * wr_[4 * f4] + z[1] * wr_[4 * f4 + 1] + z[2] * wr_[4 * f4 + 2] + z[3] * wr_[4 * f4 + 3]; }
          hB[p * 68 + u] = sin_rev(fr * s); } }
    __syncthreads();
    { const int u = tid & 63; const float fr = frq[u], bb = b3[u]; float wr_[64];
#pragma unroll
      for (int f = 0; f < 64; ++f) wr_[f] = w3[f * 64 + u];
#pragma unroll 1
      for (int p = tid >> 6; p < 64; p += 8) { float s = bb;
#pragma unroll
          for (int f4 = 0; f4 < 16; ++f4) { const f32x4 z = *(const f32x4*)(hB + p * 68 + 4 * f4); s += z[0] * wr_[4 * f4] + z[1] * wr_[4 * f4 + 1] + z[2] * wr_[4 * f4 + 2] + z[3] * wr_[4 * f4 + 3]; }
          hA[u * 68 + p] = sin_rev(fr * s); } }
    __syncthreads();
    const int c = tid & 255, phh = tid >> 8;
    const float adelta = 3.0701134573253945f + (float)c * ((15.350567286626973f - 3.0701134573253945f) / 255.0f);
    float* raw = (float*)((unsigned char*)(GAS unsigned char*)a->ws + WS_KK); float* psum = (float*)((unsigned char*)(GAS unsigned char*)a->ws + WS_PSUM);
    float* W4s = (float*)(C.lds + 49152);
#pragma unroll 1
    for (int q = 0; q < 4; ++q) {
#pragma unroll
        for (int it = 0; it < 8; ++it) { const int i = tid + it * 512; const int k = i >> 6, c4 = i & 63; *(f32x4*)(W4s + k * 256 + 4 * c4) = *(const f32x4*)(w4 + (size_t)k * 1024 + q * 256 + 4 * c4); }
        __syncthreads();
        float s = 0.f;
        float* dst = raw + ((size_t)((ly * 4 + q) * 256 + c)) * 8192 + l0 + 32 * phh;
#pragma unroll 1
        for (int half = 0; half < 2; ++half) {
            float acc[16];
#pragma unroll
            for (int p = 0; p < 16; ++p) acc[p] = 0.f;
            const float* hp = hA + 32 * phh + 16 * half;
#pragma unroll 4
            for (int k = 0; k < 64; ++k) { const float w = W4s[k * 256 + c];
                const f32x4 h0 = *(const f32x4*)(hp + k * 68), h1 = *(const f32x4*)(hp + k * 68 + 4), h2 = *(const f32x4*)(hp + k * 68 + 8), h3 = *(const f32x4*)(hp + k * 68 + 12);
#pragma unroll
                for (int e = 0; e < 4; ++e) { acc[e] += h0[e] * w; acc[4 + e] += h1[e] * w; acc[8 + e] += h2[e] * w; acc[12 + e] += h3[e] * w; } }
#pragma unroll
            for (int p = 0; p < 16; ++p) { const int l = l0 + 32 * phh + 16 * half + p; const float t = (float)l / 8191.0f; acc[p] *= __expf(-t * adelta); if (!((q & 1) && l == 0)) s += fabsf(acc[p]); }
#pragma unroll
            for (int p = 0; p < 16; p += 4) *(f32x4*)(dst + 16 * half + p) = (f32x4){acc[p], acc[p + 1], acc[p + 2], acc[p + 3]};
        }
        if (phh == 1) ps[c] = s;
        __syncthreads();
        if (phh == 0) psum[((size_t)(ly * 128 + ch)) * 1024 + q * 256 + c] = s + ps[c];
    }
}
__device__ __forceinline__ void cast_rows(const Ctx& C, const float* x, bf16_t* xb, float* rss) {
    for (int m = C.gw; m < MTOK; m += C.NGW) {
        const f32x4* xr = (const f32x4*)(x + (size_t)m * DM) + C.lane; f32x4 v[4]; float s = 0.f;
#pragma unroll
        for (int j = 0; j < 4; ++j) { v[j] = xr[64 * j]; s += (v[j].x * v[j].x + v[j].y * v[j].y) + (v[j].z * v[j].z + v[j].w * v[j].w); }
        s = wave_sum(s); if (C.lane == 0) *(f32x4*)(rss + 4 * (size_t)m) = (f32x4){s, 0.f, 0.f, 0.f};
        u32x2* o8 = (u32x2*)(xb + (size_t)m * DM) + C.lane;
#pragma unroll
        for (int j = 0; j < 4; ++j) o8[64 * j] = (u32x2){pk2(v[j].x, v[j].y), pk2(v[j].z, v[j].w)};
    }
}
__device__ __forceinline__ void final_norm_rows(const Ctx& C, const bf16_t* xb, const float* rss, float* out, const float* g) {
    f32x4 gg[4];
#pragma unroll
    for (int j = 0; j < 4; ++j) gg[j] = ((const f32x4*)g)[C.lane + 64 * j];
    for (int m = C.gw; m < MTOK; m += 2 * C.NGW) {
        const int m2 = (m + C.NGW < MTOK) ? m + C.NGW : m;
        const u32x2* xr = (const u32x2*)(xb + (size_t)m * DM) + C.lane; const u32x2* xr2 = (const u32x2*)(xb + (size_t)m2 * DM) + C.lane; u32x2 v[4], w[4];
        const f32x4 s1 = *(const f32x4*)(rss + 4 * (size_t)m), s2 = *(const f32x4*)(rss + 4 * (size_t)m2);
#pragma unroll
        for (int j = 0; j < 4; ++j) { v[j] = xr[64 * j]; w[j] = xr2[64 * j]; }
        const float rstd = rsqrtf(((s1[0] + s1[1]) + (s1[2] + s1[3])) * (1.f / DM) + EPS), rstd2 = rsqrtf(((s2[0] + s2[1]) + (s2[2] + s2[3])) * (1.f / DM) + EPS);
        f32x4* o1 = (f32x4*)(out + (size_t)m * DM) + C.lane; f32x4* o2 = (f32x4*)(out + (size_t)m2 * DM) + C.lane;
#pragma unroll
        for (int j = 0; j < 4; ++j) o1[64 * j] = (f32x4){bflo(v[j].x), bfhi(v[j].x), bflo(v[j].y), bfhi(v[j].y)} * rstd * gg[j];
        if (m2 != m) {
#pragma unroll
            for (int j = 0; j < 4; ++j) o2[64 * j] = (f32x4){bflo(w[j].x), bfhi(w[j].x), bflo(w[j].y), bfhi(w[j].y)} * rstd2 * gg[j]; }
    }
}
__device__ __forceinline__ void group_norm_tile(const Ctx& C, bf16_t* y, const bf16_t* yhyT, int tile) {
    constexpr int TS = 72;
    bf16_t* T = (bf16_t*)C.lds;
    const int tid = C.tid, lane = C.lane; const int row0 = tile * 64; const int b = row0 >> 13, l0 = row0 & 8191;
    __syncthreads();
    { const int c = tid >> 1, hf = tid & 1; const bf16_t* src = yhyT + ((size_t)(b * 256 + c)) * SEQ + l0 + hf * 32;
      u32x4 v[4];
#pragma unroll
      for (int e = 0; e < 4; ++e) v[e] = *(const u32x4*)(src + 8 * e);
#pragma unroll
      for (int e = 0; e < 4; ++e) *(u32x4*)(T + c * TS + hf * 32 + 8 * e) = v[e]; }
    __syncthreads();
#pragma unroll 2
    for (int p = C.wave * 8; p < C.wave * 8 + 8; ++p) {
        u32x2* yr = (u32x2*)(y + (size_t)(row0 + p) * DM) + lane; float v[4][4]; float ss[4];
#pragma unroll
        for (int j = 0; j < 3; ++j) { const u32x2 w = yr[64 * j]; v[j][0] = bflo(w.x); v[j][1] = bfhi(w.x); v[j][2] = bflo(w.y); v[j][3] = bfhi(w.y); }
#pragma unroll
        for (int e = 0; e < 4; ++e) v[3][e] = bf2f(T[(4 * lane + e) * TS + p]);
#pragma unroll
        for (int j = 0; j < 4; ++j) ss[j] = (v[j][0] * v[j][0] + v[j][1] * v[j][1]) + (v[j][2] * v[j][2] + v[j][3] * v[j][3]);
        const float s0 = wave_sum(ss[0] + ss[1]), s1 = wave_sum(ss[2]), s2 = wave_sum(ss[3]);
        float r[4]; r[0] = r[1] = rsqrtf(s0 * (1.f / 512.f) + EPS); r[2] = rsqrtf(s1 * (1.f / 256.f) + EPS); r[3] = rsqrtf(s2 * (1.f / 256.f) + EPS);
#pragma unroll
        for (int j = 0; j < 4; ++j) yr[64 * j] = (u32x2){pk2(v[j][0] * r[j], v[j][1] * r[j]), pk2(v[j][2] * r[j], v[j][3] * r[j])};
    }
}
__device__ __forceinline__ void prep_rows(const Ctx& C, const bf16_t* h, bf16_t* A2, bf16_t* kper, bf16_t* uconv, const float* cs) {
    const int lane = C.lane;
    struct RowIn { u32x2 wq, wa, wg; unsigned wkv; float x1, x2, c, s; };
    auto ld = [&](int m) { RowIn r; const bf16_t* hp = h + (size_t)m * INPAD;
        r.wq = *((const u32x2*)hp + lane); r.wkv = *((const unsigned*)(hp + 256) + lane);
        r.wa = *((const u32x2*)(hp + OFF_CONV) + lane); r.wg = *((const u32x2*)(hp + OFF_CONV + 256) + lane);
        const int l16 = lane & 15; r.x1 = bf2f(hp[OFF_KPE + l16]); r.x2 = bf2f(hp[OFF_KPE + 16 + l16]); r.c = cs[(size_t)m * 32 + l16]; r.s = cs[(size_t)m * 32 + 16 + l16]; return r; };
    int m = C.gw; if (m >= MTOK) return;
    RowIn cur = ld(m);
    for (; m < MTOK; m += C.NGW) {
        const int mn = (m + C.NGW < MTOK) ? m + C.NGW : m;
        const RowIn nxt = ld(mn);
        const u32x2 wq = cur.wq, wa = cur.wa, wg = cur.wg; const unsigned wkv = cur.wkv;
        const float q0 = bflo(wq.x), q1 = bfhi(wq.x), q2 = bflo(wq.y), q3 = bfhi(wq.y), k0 = bflo(wkv), k1 = bfhi(wkv);
        const float rq = rsqrtf(wave_sum((q0 * q0 + q1 * q1) + (q2 * q2 + q3 * q3)) * (1.f / 256.f) + EPS);
        const float rk = rsqrtf(wave_sum(k0 * k0 + k1 * k1) * (1.f / 128.f) + EPS);
        *((u32x2*)(A2 + (size_t)m * KQKV) + lane) = (u32x2){pk2(q0 * rq, q1 * rq), pk2(q2 * rq, q3 * rq)};
        *((unsigned*)(A2 + (size_t)m * KQKV + 256) + lane) = pk2(k0 * rk, k1 * rk);
        { const float a0 = bflo(wa.x), a1 = bfhi(wa.x), a2 = bflo(wa.y), a3 = bfhi(wa.y), g0 = bflo(wg.x), g1 = bfhi(wg.x), g2 = bflo(wg.y), g3 = bfhi(wg.y);
          *((u32x2*)(uconv + (size_t)m * 256) + lane) = (u32x2){pk2(a0 / (1.f + __expf(-g0)), a1 / (1.f + __expf(-g1))), pk2(a2 / (1.f + __expf(-g2)), a3 / (1.f + __expf(-g3)))}; }
        if (lane < 16) { kper[(size_t)m * 32 + lane] = (bf16_t)f2bf(cur.x1 * cur.c - cur.x2 * cur.s); kper[(size_t)m * 32 + 16 + lane] = (bf16_t)f2bf(cur.x1 * cur.s + cur.x2 * cur.c); }
        cur = nxt;
    }
}
__device__ __forceinline__ void hy_short_tile(const Ctx& C, const bf16_t* h, bf16_t* hyT, const float* sw, const float* sb, int tile) {
    constexpr int RS = 776;
    bf16_t* T = (bf16_t*)C.lds;
    const int tid = C.tid; const int row0 = tile * 64; const int b = row0 >> 13, l0 = row0 & 8191;
    __syncthreads();
#pragma unroll 4
    for (int i = tid; i < 66 * 96; i += 512) { const int r = i / 96, cc = i - 96 * r; const int l = l0 - 1 + r;
        u32x4 v = (u32x4){0u, 0u, 0u, 0u}; if (l >= 0 && l < SEQ) v = *(const u32x4*)(h + (size_t)(b * SEQ + l) * INPAD + OFF_HY + cc * 8);
        *(u32x4*)(T + r * RS + cc * 8) = v; }
    __syncthreads();
    for (int w = tid; w < 768 * 8; w += 512) { const int pg = w & 7, ch = w >> 3;
        const float w0 = sw[ch], w1 = sw[768 + ch], w2 = sw[1536 + ch], bb = sb[ch];
        float x[10];
#pragma unroll
        for (int r = 0; r < 10; ++r) x[r] = bf2f(T[(8 * pg + r) * RS + ch]);
        u32x4 o; o.x = pk2(bb + w0 * x[0] + w1 * x[1] + w2 * x[2], bb + w0 * x[1] + w1 * x[2] + w2 * x[3]); o.y = pk2(bb + w0 * x[2] + w1 * x[3] + w2 * x[4], bb + w0 * x[3] + w1 * x[4] + w2 * x[5]);
        o.z = pk2(bb + w0 * x[4] + w1 * x[5] + w2 * x[6], bb + w0 * x[5] + w1 * x[6] + w2 * x[7]); o.w = pk2(bb + w0 * x[6] + w1 * x[7] + w2 * x[8], bb + w0 * x[7] + w1 * x[8] + w2 * x[9]);
        const int g = ch >> 8, cc = ch & 255;
        *(u32x4*)(hyT + ((size_t)((g * NB + b) * 256 + cc)) * SEQ + l0 + 8 * pg) = o; }
}
__device__ __forceinline__ void conv_tile(const Ctx& C, const bf16_t* uconv, bf16_t* y, const float* dw, const float* db, const float* lg, const float* lb, int tile) {
    bf16_t* U = (bf16_t*)C.lds;
    float* O = (float*)(C.lds + 94 * 512);
    const int tid = C.tid; const int row0 = tile * 64; const int b = row0 >> 13, l0 = row0 & 8191;
    __syncthreads();
#pragma unroll 6
    for (int i = tid; i < 94 * 32; i += 512) { const int r = i >> 5, cc = i & 31; const int l = l0 - 15 + r;
        u32x4 v = (u32x4){0u, 0u, 0u, 0u}; if (l >= 0 && l < SEQ) v = *(const u32x4*)(uconv + (size_t)(b * SEQ + l) * 256 + cc * 8);
        *(u32x4*)(U + r * 256 + cc * 8) = v; }
    __syncthreads();
    { const int c = tid & 255, phh = tid >> 8;
      float w[31], acc[32];
#pragma unroll
      for (int j = 0; j < 31; ++j) w[j] = dw[j * 256 + c];
      const float bb = db[c];
#pragma unroll
      for (int p = 0; p < 32; ++p) acc[p] = bb;
#pragma unroll
      for (int q = 0; q < 62; ++q) { const float val = bf2f(U[(32 * phh + q) * 256 + c]);
#pragma unroll
          for (int p = 0; p < 32; ++p) if (q - p >= 0 && q - p <= 30) acc[p] += w[q - p] * val; }
#pragma unroll
      for (int p = 0; p < 32; ++p) O[(32 * phh + p) * 260 + c] = acc[p]; }
    __syncthreads();
    { const int lane = C.lane; const f32x4 gg = ((const f32x4*)lg)[lane], be = ((const f32x4*)lb)[lane];
      for (int p = C.wave * 8; p < C.wave * 8 + 8; ++p) { const f32x4 v = *(const f32x4*)(O + p * 260 + 4 * lane);
          const float mean = wave_sum((v[0] + v[1]) + (v[2] + v[3])) * (1.f / 256.f); const f32x4 d = v - mean;
          const float rstd = rsqrtf(wave_sum((d[0] * d[0] + d[1] * d[1]) + (d[2] * d[2] + d[3] * d[3])) * (1.f / 256.f) + EPS);
          const f32x4 t = d * rstd * gg + be; float o[4];
#pragma unroll
          for (int e = 0; e < 4; ++e) o[e] = t[e] / (1.f + __expf(-t[e]));
          *((u32x2*)(y + (size_t)(row0 + p) * DM + 512) + lane) = (u32x2){pk2(o[0], o[1]), pk2(o[2], o[3])}; } }
}
__device__ __forceinline__ void hyena_item(const Ctx& C, ArgsP a, int ly, int c, bf16_t* yout) {
    constexpr int US = 144, DG = 8, WW = 128 * DG + 144;
    constexpr int OFF_R = 4 * 64 * US * 2, OFF_W = OFF_R + 32768, OFF_RED = OFF_W + 2 * 8 * WW * 2;
    bf16_t* U = (bf16_t*)C.lds;
    bf16_t* R = (bf16_t*)(C.lds + OFF_R);
    bf16_t* Wn = (bf16_t*)(C.lds + OFF_W);
    float* red = (float*)(C.lds + OFF_RED);
    typedef float f32x4v __attribute__((ext_vector_type(4)));
    const int tid = C.tid, lane = C.lane, wave = C.wave; const int b = wave & 3, rh = wave >> 2; const int col = lane & 15, kq = lane >> 4;
    unsigned char* wsb = (unsigned char*)(GAS unsigned char*)a->ws;
    const bf16_t* hyT = (const bf16_t*)(wsb + WS_HYT);
    const float* raw = (const float*)(wsb + WS_KK); const float* psum = (const float*)(wsb + WS_PSUM);
    __syncthreads();
    { const bf16_t* vsrc = hyT + (size_t)c * SEQ + tid * 8; bf16_t* udst = U + (tid >> 4) * US + (tid & 15) * 8;
#pragma unroll
      for (int it = 0; it < 8; ++it) { const u32x4 v = *(const u32x4*)(vsrc + (size_t)(it >> 1) * 256 * SEQ + (it & 1) * 4096);
          *(u32x4*)(udst + ((it >> 1) * 64 + (it & 1) * 32) * US) = v; } }
    const int abase = (col & 7) * WW + 128 + 8 * kq - 8 * (col >> 3) - 64 * rh;
    for (int o = 0; o < 2; ++o) {
        { float v = 0.f; if (tid < 256) v = psum[((size_t)(ly * 128 + (tid & 127))) * 1024 + o * 512 + (tid >> 7) * 256 + c];
          v = wave_sum(v); if (lane == 0) red[wave] = v; }
        __syncthreads();
        const float inv = 1.0f / ((red[0] + red[1]) + (red[2] + red[3]));
        const float dbias = GIN(a, 26)[(ly * 2 + o) * 256 + c];
        const float* rf = raw + ((size_t)((ly * 4 + o * 2 + 0) * 256 + c)) * 8192; const float* rb = raw + ((size_t)((ly * 4 + o * 2 + 1) * 256 + c)) * 8192;
        { f32x4 vf[4], vb[4];
#pragma unroll
          for (int it = 0; it < 4; ++it) { vf[it] = *(const f32x4*)(rf + 4 * (tid + it * 512)); vb[it] = *(const f32x4*)(rb + 4 * (tid + it * 512)); }
#pragma unroll
          for (int it = 0; it < 4; ++it)
#pragma unroll
              for (int e = 0; e < 4; ++e) { const int l = 4 * (tid + it * 512) + e; float f = vf[it][e] * inv; if (l == 0) f += dbias;
                  R[8192 - l] = (bf16_t)f2bf(f); if (l >= 1) R[8192 + l] = (bf16_t)f2bf(vb[it][e] * inv); else R[0] = 0; } }
        f32x4v acc[4][4];
#pragma unroll
        for (int i = 0; i < 4; ++i)
#pragma unroll
            for (int j = 0; j < 4; ++j) acc[i][j] = (f32x4v){0.f, 0.f, 0.f, 0.f};
        __syncthreads();
        for (int g = 0; g < 128 / DG; ++g) {
            const int dlo = -64 + DG * g, dhi = dlo + DG - 1;
            bf16_t* Wb = Wn + (g & 1) * (8 * WW);
            const int xs = 8192 - 128 * dhi - 128;
            { bf16_t* dst = Wb + wave * WW; const int x0 = xs - wave;
              bf16_t tv[19];
#pragma unroll
              for (int it = 0; it < 19; ++it) { const int yy = lane + 64 * it; const int xi = x0 + yy; tv[it] = (yy < WW && xi >= 0 && xi < 16384) ? R[xi] : (bf16_t)0; }
#pragma unroll
              for (int it = 0; it < 19; ++it) { const int yy = lane + 64 * it; if (yy < WW) dst[yy] = tv[it]; } }
            __syncthreads();
#define HY_MMA(CT) { const int s1 = 16 * (CT) + col - d; const bool ok = (s1 >= 0 && s1 < 64); const bf16_t* up = U + (b * 64 + (ok ? s1 : 0)) * US + 8 * kq; \
            bf16x8 bvs[4]; \
            _Pragma("unroll") for (int jj = 0; jj < 4; ++jj) bvs[jj] = *(const bf16x8*)(up + 32 * jj); \
            __builtin_amdgcn_sched_barrier(0); __builtin_amdgcn_s_setprio(1); \
            _Pragma("unroll") for (int jj = 0; jj < 4; ++jj) { bf16x8 bv = bvs[jj]; if (!ok) bv = (bf16x8){0, 0, 0, 0, 0, 0, 0, 0}; \
                _Pragma("unroll") for (int ii = 0; ii < 4; ++ii) acc[ii][CT] = __builtin_amdgcn_mfma_f32_16x16x32_bf16(fa[2 * jj - ii + 3], bv, acc[ii][CT], 0, 0, 0); } \
            __builtin_amdgcn_s_setprio(0); }
            for (int dd = 0; dd < DG; ++dd) { const int d = dlo + dd; if (d == -64) continue;
                const bf16_t* Wd = Wb + abase + 128 * (DG - 1 - dd);
                bf16x8 fa[10];
#pragma unroll
                for (int q = 0; q < 10; ++q) fa[q] = *(const bf16x8*)(Wd + 16 * (q - 3));
                if (d <= 15) HY_MMA(0)
                if (d >= -47 && d <= 31) HY_MMA(1)
                if (d >= -31 && d <= 47) HY_MMA(2)
                if (d >= -15) HY_MMA(3)
            }
#undef HY_MMA
        }
        __syncthreads();
        const bf16_t* xg = hyT + ((size_t)(((o + 1) * NB + b) * 256 + c)) * SEQ + col * 128 + 4 * kq + 64 * rh;
        bf16_t* Ul = U + (b * 64 + col) * US + 4 * kq + 64 * rh;
#pragma unroll
        for (int ct = 0; ct < 4; ++ct) {
#pragma unroll
            for (int ii = 0; ii < 4; ++ii)
#pragma unroll
                for (int r = 0; r < 4; ++r) { const float val = bf2f(xg[2048 * ct + 16 * ii + r]) * acc[ii][ct][r]; Ul[16 * ct * US + 16 * ii + r] = (bf16_t)f2bf(val); }
            asm volatile("" ::: "memory"); }
        __syncthreads();
        if (o == 1) {
            bf16_t* ydst = yout + (size_t)c * SEQ + tid * 8; const bf16_t* usrc = U + (tid >> 4) * US + (tid & 15) * 8;
#pragma unroll
            for (int it = 0; it < 8; ++it) *(u32x4*)(ydst + (size_t)(it >> 1) * 256 * SEQ + (it & 1) * 4096) = *(const u32x4*)(usrc + ((it >> 1) * 64 + (it & 1) * 32) * US);
        }
    }
}
#define XB_TMO      128
#define XB_XCNT(j)  (256  + 64 * (j))
#define XB_XSUB(j)  (1280 + 64 * (j))
#define XB_XGEN(j)  (2304 + 64 * (j))
#define XB_TOP      3328
#define XB_TOPGEN   3392
#define XCD_BAR_WORDS 3456
#define XB_SPIN_CAP (1u << 18)

__device__ __forceinline__ unsigned xb_ld(unsigned* p)              { return __hip_atomic_load(p, __ATOMIC_RELAXED, __HIP_MEMORY_SCOPE_AGENT); }
__device__ __forceinline__ unsigned xb_add(unsigned* p, unsigned v) { return __hip_atomic_fetch_add(p, v, __ATOMIC_RELAXED, __HIP_MEMORY_SCOPE_AGENT); }
__device__ __forceinline__ unsigned xb_xcc_id() { return (unsigned)__builtin_amdgcn_s_getreg((3 << 11) | 20) & 0xFu; }
#define XB_SPIN(cond, bar) do { unsigned _sp = 0; while (cond) { __builtin_amdgcn_s_sleep(1); \
    if ((++_sp & 255u) == 0u) { if (xb_ld(&(bar)[XB_TMO])) break; if (_sp > XB_SPIN_CAP) { atomicAdd(&(bar)[XB_TMO], 1u); break; } } } } while (0)

struct XcdBarrier {
    unsigned* bar; unsigned x;
    volatile LAS unsigned* st;
};

__device__ __forceinline__ XcdBarrier xcd_barrier_post(unsigned* bar, volatile LAS unsigned* st) {
    XcdBarrier b; b.bar = bar; b.x = xb_xcc_id(); b.st = st;
    if (threadIdx.x == 0) (void)xb_add(&bar[XB_XCNT(b.x)], 1u);
    return b;
}
__device__ __forceinline__ void xcd_barrier_complete(unsigned* bar, unsigned x, unsigned& nloc, unsigned& nx) {
    const unsigned G = gridDim.x * gridDim.y * gridDim.z;
    unsigned sum, cnt, mine, sp = 0u;
    for (;;) {
        sum = 0u; cnt = 0u; mine = 0u;
#pragma unroll
        for (unsigned j = 0; j < 16; ++j) { const unsigned c = xb_ld(&bar[XB_XCNT(j)]); sum += c; cnt += (c > 0u) ? 1u : 0u; mine = (j == x) ? c : mine; }
        if (sum == G) break;
        __builtin_amdgcn_s_sleep(1);
        if ((++sp & 255u) == 0u) { if (xb_ld(&bar[XB_TMO])) break; if (sp > XB_SPIN_CAP) { atomicAdd(&bar[XB_TMO], 1u); break; } }
    }
    nloc = mine > 0u ? mine : 1u; nx = cnt > 0u ? cnt : 1u;
}

__device__ __forceinline__ void xcd_barrier(const XcdBarrier& b) {
    asm volatile("s_waitcnt vmcnt(0)" ::: "memory");
    __syncthreads();
    if (threadIdx.x == 0) {
        unsigned* bar = b.bar;
        __builtin_amdgcn_s_waitcnt(0);
        unsigned nloc = b.st[0], nx = b.st[1];
        if (nloc == 0u) { xcd_barrier_complete(bar, b.x, nloc, nx); b.st[0] = nloc; b.st[1] = nx; }
        const unsigned old = xb_add(&bar[XB_XSUB(b.x)], 1u);
        const unsigned gen = old / nloc;
        if (old + 1u == (gen + 1u) * nloc) {
            __builtin_amdgcn_fence(__ATOMIC_RELEASE, "agent");
            asm volatile("s_waitcnt vmcnt(0)" ::: "memory");
            const unsigned og = xb_add(&bar[XB_TOP], 1u);
            const unsigned tg = og / nx;
            if (og + 1u == (tg + 1u) * nx) xb_add(&bar[XB_TOPGEN], 1u);
            else XB_SPIN(xb_ld(&bar[XB_TOPGEN]) == tg, bar);
            __builtin_amdgcn_fence(__ATOMIC_ACQUIRE, "agent");
            xb_add(&bar[XB_XGEN(b.x)], 1u);
            asm volatile("s_waitcnt vmcnt(0)" ::: "memory");
        } else {
            XB_SPIN(xb_ld(&bar[XB_XGEN(b.x)]) == gen, bar);
            __builtin_amdgcn_fence(__ATOMIC_ACQUIRE, "agent");
            asm volatile("s_waitcnt vmcnt(0)" ::: "memory");
        }
    }
    __syncthreads();
}

namespace att {
constexpr int QBLK = 32, KVBLK = 64;
constexpr float SCALE = 0.10206207261596575f;
constexpr float THR = 8.f;
constexpr int SHM_V = 16384, SHM_K = 16384, SLOT = 16384;
#define KSWZ(row, colB) ((row) * 256 + ((colB) ^ (((row) & 7) << 4)))
#define SBAR() __builtin_amdgcn_sched_barrier(0)
__device__ __forceinline__ int crow(int r, int hi) { return (r & 3) + 8 * (r >> 2) + 4 * hi; }
__device__ __forceinline__ unsigned cvtpk(float lo, float hi) { unsigned r; asm volatile("v_cvt_pk_bf16_f32 %0, %1, %2" : "=v"(r) : "v"(lo), "v"(hi)); return r; }
constexpr float THRL = 8.f * 1.4426950408889634f;
template <bool FIRST> __device__ __forceinline__ void partialSM(f32x16& p0, f32x16& p1, float& mhat, f32x16& negm, float& alpha) {
  float pa = fmaxf(fmaxf(p0[0], p0[1]), p1[0]), pb = fmaxf(fmaxf(p0[2], p0[3]), p1[1]); pa = fmaxf(fmaxf(pa, p1[2]), p1[3]);
#pragma unroll
  for (int r = 4; r < 16; r += 4) { pa = fmaxf(fmaxf(pa, p0[r]), p0[r + 1]); pb = fmaxf(fmaxf(pb, p0[r + 2]), p0[r + 3]); pa = fmaxf(fmaxf(pa, p1[r]), p1[r + 1]); pb = fmaxf(fmaxf(pb, p1[r + 2]), p1[r + 3]); }
  float pmax = fmaxf(pa, pb);
  { auto rr = __builtin_amdgcn_permlane32_swap(__float_as_uint(pmax), __float_as_uint(pmax), false, false);
    pmax = fmaxf(__uint_as_float(rr[0]), __uint_as_float(rr[1])); }
  if (!FIRST && __builtin_expect(__all(pmax <= THRL), 1)) { alpha = 1.f; }
  else { const float d = FIRST ? pmax : fmaxf(pmax, 0.f); mhat += d; alpha = FIRST ? 1.f : __builtin_amdgcn_exp2f(-d);
#pragma unroll
    for (int r = 0; r < 16; ++r) { p0[r] -= d; p1[r] -= d; }
#pragma unroll
    for (int r = 0; r < 16; ++r) negm[r] = -mhat; }
#pragma unroll
  for (int r = 0; r < 16; ++r) p0[r] = __builtin_amdgcn_exp2f(p0[r]);
}
__device__ __forceinline__ void finishSM(f32x16& p0, f32x16& p1, float alpha, float& l_reg, bf16x8& pa0, bf16x8& pa1, bf16x8& pa2, bf16x8& pa3) {
#pragma unroll
  for (int r = 0; r < 16; ++r) p1[r] = __builtin_amdgcn_exp2f(p1[r]);
  float ps = 0;
#pragma unroll
  for (int r = 0; r < 16; ++r) ps += p0[r];
#pragma unroll
  for (int r = 0; r < 16; ++r) ps += p1[r];
  { auto rr = __builtin_amdgcn_permlane32_swap(__float_as_uint(ps), __float_as_uint(ps), false, false);
    ps = __uint_as_float(rr[0]) + __uint_as_float(rr[1]); }
  l_reg = l_reg * alpha + ps;
#define PK4(P, BASE, OUT) do { unsigned a0 = cvtpk(P[BASE + 0], P[BASE + 1]), a1 = cvtpk(P[BASE + 2], P[BASE + 3]);   \
    unsigned b0 = cvtpk(P[BASE + 4], P[BASE + 5]), b1 = cvtpk(P[BASE + 6], P[BASE + 7]);                              \
    auto r0 = __builtin_amdgcn_permlane32_swap(a0, b0, false, false); auto r1 = __builtin_amdgcn_permlane32_swap(a1, b1, false, false); \
    u32x4 w = {r0[0], r1[0], r0[1], r1[1]}; OUT = *reinterpret_cast<bf16x8*>(&w); } while (0)
  PK4(p0, 0, pa0); PK4(p0, 8, pa1); PK4(p1, 0, pa2); PK4(p1, 8, pa3);
#undef PK4
}
__device__ __forceinline__ void qkt(f32x16& p0, f32x16& p1, const bf16_t* Ks, const bf16x8* qr, const f32x16& negm, int r32, int hi) {
  p0 = negm; p1 = negm;
#pragma unroll
  for (int d0 = 0; d0 < 6; ++d0) { int cb = (d0 * 16 + hi * 8) * 2;
    bf16x8 b0 = *reinterpret_cast<const bf16x8*>((const char*)Ks + KSWZ(r32, cb));
    bf16x8 b1 = *reinterpret_cast<const bf16x8*>((const char*)Ks + KSWZ(32 + r32, cb));
    p0 = __builtin_amdgcn_mfma_f32_32x32x16_bf16(b0, qr[d0], p0, 0, 0, 0);
    p1 = __builtin_amdgcn_mfma_f32_32x32x16_bf16(b1, qr[d0], p1, 0, 0, 0); }
}
__device__ __forceinline__ int v_st(int k, int c) { const int kk = (k & ~0xC) | ((k & 4) << 1) | ((k & 8) >> 1); return ((kk >> 3) * 4 + (c >> 5)) * 512 + ((kk & 7) * 32 + (c & 31)) * 2; }
__device__ __forceinline__ int v_rd_base(int lane) { return ((lane & 3) << 3) | (((lane >> 2) & 3) << 6) | (((lane >> 4) & 1) << 5) | (((lane >> 5) & 1) << 8); }
constexpr int v_rd_off(int d0, int ks, int half) { return d0 * 512 + ks * 4096 + half * 2048; }
template <int OFF> __device__ __forceinline__ s16x4 tr_read(int vb) {
  s16x4 r; asm volatile("ds_read_b64_tr_b16 %0, %1 offset:%2" : "=&v"(r) : "v"(vb), "i"(OFF) : "memory"); return r;
}
template <int D0> __device__ __forceinline__ void pv_one(f32x16& od, int vb, bf16x8 pa0, bf16x8 pa1, bf16x8 pa2, bf16x8 pa3) {
  const s16x4 l0 = tr_read<v_rd_off(D0, 0, 0)>(vb), h0 = tr_read<v_rd_off(D0, 0, 1)>(vb), l1 = tr_read<v_rd_off(D0, 1, 0)>(vb), h1 = tr_read<v_rd_off(D0, 1, 1)>(vb);
  const s16x4 l2 = tr_read<v_rd_off(D0, 2, 0)>(vb), h2 = tr_read<v_rd_off(D0, 2, 1)>(vb), l3 = tr_read<v_rd_off(D0, 3, 0)>(vb), h3 = tr_read<v_rd_off(D0, 3, 1)>(vb);
  asm volatile("s_waitcnt lgkmcnt(0)" ::: "memory"); SBAR();
#define PK(L, H) (bf16x8){L[0], L[1], L[2], L[3], H[0], H[1], H[2], H[3]}
  od = __builtin_amdgcn_mfma_f32_32x32x16_bf16(pa0, PK(l0, h0), od, 0, 0, 0);
  od = __builtin_amdgcn_mfma_f32_32x32x16_bf16(pa1, PK(l1, h1), od, 0, 0, 0);
  od = __builtin_amdgcn_mfma_f32_32x32x16_bf16(pa2, PK(l2, h2), od, 0, 0, 0);
  od = __builtin_amdgcn_mfma_f32_32x32x16_bf16(pa3, PK(l3, h3), od, 0, 0, 0);
#undef PK
}
__device__ __forceinline__ void pv_d0(f32x16* o, int vb, bf16x8 pa0, bf16x8 pa1, bf16x8 pa2, bf16x8 pa3) {
  pv_one<0>(o[0], vb, pa0, pa1, pa2, pa3); pv_one<1>(o[1], vb, pa0, pa1, pa2, pa3);
}
__device__ __forceinline__ void attn_item(const bf16_t* __restrict__ Qb, const bf16_t* __restrict__ Kn, const bf16_t* __restrict__ Kr, const bf16_t* __restrict__ Vh,
                                          const float* __restrict__ csq, bf16_t* __restrict__ Ob, int seq, char* lds) {
  int tid_ = threadIdx.x; asm volatile("" : "+v"(tid_));
  const int tid = tid_, wid = tid >> 6, lane = tid & 63, r32 = lane & 31, hi = lane >> 5;
  bf16_t* V_lds = (bf16_t*)lds; bf16_t* K_lds = (bf16_t*)(lds + 3 * SLOT);
  float* ws = (float*)(lds + 6 * SLOT) + wid * 64; float* li_l = ws; float* al_l = ws + 32;
  float mhat = 0.f, l_reg = 0; f32x16 o[2] = {}; bf16x8 qr[6]; f32x16 negm = f32x16{};
  const bf16_t* Qw = Qb + (long)(wid * QBLK + r32) * 1792 + hi * 8;
#pragma unroll
  for (int d0 = 0; d0 < 6; ++d0) qr[d0] = *reinterpret_cast<const bf16x8*>(Qw + d0 * 16);
  { const float* cp = csq + (long)(wid * QBLK + r32) * 32 + hi * 8;
    const f32x4 c0 = *(const f32x4*)cp, c1 = *(const f32x4*)(cp + 4), s0 = *(const f32x4*)(cp + 16), s1 = *(const f32x4*)(cp + 20);
    float cc[8] = {c0[0], c0[1], c0[2], c0[3], c1[0], c1[1], c1[2], c1[3]}, ss[8] = {s0[0], s0[1], s0[2], s0[3], s1[0], s1[1], s1[2], s1[3]};
    bf16x8 n4, n5;
#pragma unroll
    for (int e = 0; e < 8; ++e) { const float x1 = bf2f((unsigned short)qr[4][e]), x2 = bf2f((unsigned short)qr[5][e]);
      n4[e] = (short)f2bf(x1 * cc[e] - x2 * ss[e]); n5[e] = (short)f2bf(x1 * ss[e] + x2 * cc[e]); }
    qr[4] = n4; qr[5] = n5; }
  const int sr = tid >> 3, sc = (tid & 7) * 8, vst0 = v_st(sr, sc);
  const int rr_ = (tid & 255) >> 2, rc_ = (tid & 3) * 8;
  const int vb0 = (int)(uintptr_t)V_lds + v_rd_base(lane);
  struct { bf16x8 vs, kn, kr; } sr_[1];
#define SLOAD(i, k0) do { sr_[i].vs = *reinterpret_cast<const bf16x8*>(&Vh[(long)((k0) + sr) * 1792 + sc]); sr_[i].kn = *reinterpret_cast<const bf16x8*>(&Kn[(long)((k0) + sr) * 1792 + sc]); \
    sr_[i].kr = *reinterpret_cast<const bf16x8*>(&Kr[(long)((k0) + rr_) * 32 + rc_]); } while (0)
#define SWRITE(off, i) do { *(bf16x8*)((char*)V_lds + (off) + vst0) = sr_[i].vs;          \
    *(bf16x8*)((char*)K_lds + (off) + KSWZ(sr, sc * 2)) = sr_[i].kn;                       \
    if (tid < 256) *(bf16x8*)((char*)K_lds + (off) + KSWZ(rr_, 128 + rc_ * 2)) = sr_[i].kr; } while (0)
#define SWAIT() asm volatile("s_waitcnt vmcnt(0)" ::: "memory")
#define RESC(a) do { if (__any((a) < 1.f)) { if (hi == 0) al_l[r32] = (a); asm volatile("s_waitcnt lgkmcnt(0)" ::: "memory"); \
    _Pragma("unroll") for (int d = 0; d < 2; ++d) _Pragma("unroll") for (int r = 0; r < 16; ++r) o[d][r] *= al_l[crow(r, hi)]; } } while (0)
  f32x16 pA0, pA1, pB0, pB1; float alA, alB; bf16x8 pa0, pa1, pa2, pa3; const int NT = seq / KVBLK;
  int sp = 0, scu = 0, sn = SLOT;
#define ROT() do { sp = scu; scu = sn; sn = (sn == 2 * SLOT) ? 0 : sn + SLOT; } while (0)
#define STEP(PQ0, PQ1, ALQ, PF0, PF1, ALF, T, LOADS) do { \
    SBAR(); qkt(PQ0, PQ1, (bf16_t*)((char*)K_lds + scu), qr, negm, r32, hi); \
    finishSM(PF0, PF1, ALF, l_reg, pa0, pa1, pa2, pa3); SBAR(); \
    if (LOADS) SLOAD(0, ((T) + 1) * KVBLK); SBAR(); \
    pv_d0(o, vb0 + sp, pa0, pa1, pa2, pa3); partialSM<false>(PQ0, PQ1, mhat, negm, ALQ); \
    if (LOADS) { SWAIT(); SWRITE(sn, 0); } \
    RESC(ALQ); __syncthreads(); ROT(); } while (0)
  if (__builtin_amdgcn_readfirstlane(wid) >= 4) __builtin_amdgcn_s_setprio(1);
  __syncthreads();
  SLOAD(0, 0); SWAIT(); SWRITE(0, 0); __syncthreads();
  qkt(pA0, pA1, K_lds, qr, negm, r32, hi); partialSM<true>(pA0, pA1, mhat, negm, alA);
  SLOAD(0, KVBLK); SWAIT(); SWRITE(SLOT, 0); __syncthreads();
  ROT();
  for (int j = 1; j + 1 < NT; j += 2) {
    STEP(pB0, pB1, alB, pA0, pA1, alA, j, true);
    STEP(pA0, pA1, alA, pB0, pB1, alB, j + 1, true);
  }
  STEP(pB0, pB1, alB, pA0, pA1, alA, NT - 1, false);
  finishSM(pB0, pB1, alB, l_reg, pa0, pa1, pa2, pa3); SBAR();
  pv_d0(o, vb0 + sp, pa0, pa1, pa2, pa3);
  __builtin_amdgcn_s_setprio(0);
  if (hi == 0) li_l[r32] = l_reg; asm volatile("s_waitcnt lgkmcnt(0)" ::: "memory");
  float rli[16];
#pragma unroll
  for (int r = 0; r < 16; ++r) rli[r] = __builtin_amdgcn_rcpf(li_l[crow(r, hi)]);
  bf16_t* Ow = Ob + (long)(wid * QBLK) * DM;
#pragma unroll
  for (int r = 0; r < 16; ++r) { int orow = crow(r, hi);
#pragma unroll
    for (int d0 = 0; d0 < 2; ++d0) Ow[(long)orow * DM + d0 * 32 + r32] = (bf16_t)f2bf(o[d0][r] * rli[r]); }
#undef SLOAD
#undef SWRITE
#undef SWAIT
#undef RESC
#undef STEP
#undef ROT
}
}

#ifndef DUP_ATT
#define DUP_ATT 0
#endif
#ifndef DUP_HY
#define DUP_HY 0
#endif
#ifndef DUP_GU
#define DUP_GU 0
#endif
#ifndef DUP_P0
#define DUP_P0 0
#endif
#ifndef PHMASK
#define PHMASK 0xFFFFFFFFu
#endif
template <class Epi> __device__ __forceinline__ void run_gemm(const Ctx& C, const bf16_t* A, const bf16_t* Bt, int N, int K, const Epi E) {
    asm volatile("" : "+s"(K)); asm volatile("" : "+s"(N));
    pg8::Gemm g{A, Bt, MTOK, N, K}; pg8::StaticOrder S; S.init(MTOK, N, C.G, (int)blockIdx.x);
    pg8::gemm_phase<Epi, pg8::StaticOrder, true, true>((PG8_LAS unsigned char*)C.lds, g, S, E);
}
__device__ __forceinline__ ArgsP getargs() { ArgsP p = (ArgsP)__builtin_amdgcn_kernarg_segment_ptr(); asm volatile("" : "+s"(p)); return p; }
__device__ __forceinline__ Ctx mkctx(unsigned char* lds) {
    Ctx C; { int t_ = threadIdx.x; asm volatile("" : "+v"(t_)); C.tid = t_; } C.lane = C.tid & 63; C.wave = __builtin_amdgcn_readfirstlane(C.tid >> 6);
    C.G = gridDim.x; { const int bx = blockIdx.x; C.vcu = (C.G % 8 == 0) ? (bx % 8) * (C.G / 8) + bx / 8 : bx; }
    C.gw = C.vcu * 8 + C.wave; C.NGW = C.G * 8; C.lds = (unsigned char*)(LAS unsigned char*)lds; return C;
}
__global__ void __launch_bounds__(512, 2) mega(Args a_unused) {
    extern __shared__ __attribute__((aligned(16))) unsigned char lds[];
    cg::grid_group grid = cg::this_grid();
    int ph = 0;
    if (threadIdx.x < 2) ((volatile LAS unsigned*)((LAS unsigned char*)lds + (LDS_BYTES - 64)))[threadIdx.x] = 0u;
    __syncthreads();
    { ArgsP a0 = getargs(); unsigned char* ws = (unsigned char*)(GAS unsigned char*)a0->ws; if (threadIdx.x == 0) (void)xb_add(&((unsigned*)(ws + 16384))[XB_XCNT(xb_xcc_id())], 1u); }
#define PH_BEGIN { ArgsP a = getargs(); if (ph >= a->ph_lo && ph < a->ph_hi) { const Ctx C = mkctx(lds); unsigned char* ws = (unsigned char*)(GAS unsigned char*)a->ws; (void)ws; \
    bf16_t* XN = (bf16_t*)(ws + WS_XN); bf16_t* ACT = (bf16_t*)(ws + WS_ACT); bf16_t* Hb = ACT; bf16_t* A2 = (bf16_t*)(ws + WS_A2); bf16_t* UC = (bf16_t*)(ws + WS_UCONV); \
    bf16_t* HYT = (bf16_t*)(ws + WS_HYT); bf16_t* KPE = (bf16_t*)(ws + WS_KPE); const float* CS = (const float*)(ws + WS_ROPE); const float* xin = GIN(a, 0); float* xo = (float*)(GAS float*)a->out; \
    float* RSS = (float*)(ws + WS_RSS); bf16_t* YB = (bf16_t*)xo; (void)RSS; (void)YB; (void)XN; (void)ACT; (void)Hb; (void)A2; (void)UC; (void)HYT; (void)KPE; (void)CS; (void)xin; (void)xo;
#define BAR_WORDS ((unsigned*)(ws + 16384))
#define PH_END if (ph + 1 < a->ph_hi) { \
      if (a->ph_hi < 0) grid.sync();     \
      { XcdBarrier bb; bb.bar = BAR_WORDS; bb.x = xb_xcc_id(); bb.st = (volatile LAS unsigned*)((LAS unsigned char*)lds + (LDS_BYTES - 64)); xcd_barrier(bb); } } } } ++ph;
#define REDL ((PG8_LAS float*)(PG8_LAS unsigned char*)C.lds + 131072 / 4)
#define RSSK(k) (RSS + (size_t)(k) * MTOK * 4)
#define WBL ((const bf16_t*)(ws + WS_W + (size_t)ly * WS_WLAYER))

#define PH_END_NS } }
    PH_BEGIN
        for (int rep = 0; rep <= DUP_P0; ++rep) { if constexpr (PHMASK & 1) p0_weights(C, a); }
    PH_END_NS
    PH_BEGIN
        for (int rep = 0; rep <= DUP_P0; ++rep) { if constexpr (PHMASK & 2) for (int it = C.vcu; it < DEPTH * 128; it += C.G) hyena_filter_item(C, a, it >> 7, it & 127); }
    PH_END_NS
    PH_BEGIN
        if constexpr (PHMASK & 4) cast_rows(C, xin, XN, RSSK(0));
    PH_END

    for (int ly = 0; ly < DEPTH; ++ly) {
        PH_BEGIN
            if constexpr (PHMASK & 8) for (int rep = 0; rep <= DUP_GU; ++rep) run_gemm(C, XN, WBL + WL_GU1, 2 * DFF, DM, pg8::EpiSwiGLU{ACT, DFF, RSSK(3 * ly)});
        PH_END
        PH_BEGIN
            if constexpr (PHMASK & 16) run_gemm(C, ACT, WBL + WL_D1, DM, DFF, pg8::EpiResidualBf{XN, 0.5f, RSSK(3 * ly + 1), REDL});
        PH_END
        PH_BEGIN
            if constexpr (PHMASK & 32) run_gemm(C, XN, WBL + WL_IN, INPAD, DM, pg8::EpiBf16{Hb, INPAD, RSSK(3 * ly + 1)});
        PH_END
        PH_BEGIN
            if constexpr (PHMASK & 64) prep_rows(C, Hb, A2, KPE, UC, CS);
            if constexpr (PHMASK & 128) for (int t = C.vcu; t < MTOK / 64; t += C.G) hy_short_tile(C, Hb, HYT, GIN(a, 16) + ly * 3 * 768, GIN(a, 17) + ly * 768, t);
        PH_END
        PH_BEGIN
            if constexpr (PHMASK & 256) run_gemm(C, A2, WBL + WL_QKV, NQKV, KQKV, pg8::EpiBf16{Hb, NQKV, nullptr});
        PH_END
        PH_BEGIN
            if constexpr (PHMASK & 512) for (int rep = 0; rep <= DUP_ATT; ++rep) for (int it = C.vcu; it < NB * NH * (SEQ / 256); it += C.G) { const int bh = it >> 5, qb = it & 31; const int b = bh >> 3, hh = bh & 7;
                const bf16_t* qkvb = Hb + (size_t)b * SEQ * NQKV;
                att::attn_item(qkvb + (size_t)(qb * 256) * NQKV + hh * 96, qkvb + 768 + hh * 128, KPE + (size_t)b * SEQ * 32, qkvb + 768 + hh * 128 + 64,
                               CS + (size_t)(b * SEQ + qb * 256) * 32, YB + ((size_t)(b * SEQ + qb * 256)) * DM + hh * 64, SEQ, (char*)C.lds); }
        PH_END_NS
        PH_BEGIN
            if constexpr (PHMASK & 1024) for (int t = C.vcu; t < MTOK / 64; t += C.G)
                conv_tile(C, UC, YB, GIN(a, 12) + ly * 31 * 256, GIN(a, 13) + ly * 256, GIN(a, 14) + ly * 256, GIN(a, 15) + ly * 256, t);
        PH_END_NS
        PH_BEGIN
            if constexpr (PHMASK & 2048) for (int rep = 0; rep <= DUP_HY; ++rep) for (int c = C.vcu; c < 256; c += C.G) hyena_item(C, a, ly, c, HYT);
        PH_END
        PH_BEGIN
            if constexpr (PHMASK & 4096) for (int t = C.vcu; t < MTOK / 64; t += C.G) group_norm_tile(C, YB, HYT, t);
        PH_END
        PH_BEGIN
            if constexpr (PHMASK & 16) run_gemm(C, YB, WBL + WL_OUT, DM, DM, pg8::EpiResidualBf{XN, 1.0f, RSSK(3 * ly + 2), REDL});
        PH_END
        PH_BEGIN
            if constexpr (PHMASK & 8) for (int rep = 0; rep <= DUP_GU; ++rep) run_gemm(C, XN, WBL + WL_GU2, 2 * DFF, DM, pg8::EpiSwiGLU{ACT, DFF, RSSK(3 * ly + 2)});
        PH_END
        PH_BEGIN
            if constexpr (PHMASK & 16) run_gemm(C, ACT, WBL + WL_D2, DM, DFF, pg8::EpiResidualBf{XN, 0.5f, RSSK(3 * ly + 3), REDL});
        PH_END
    }
    PH_BEGIN
        if constexpr (PHMASK & 8192) final_norm_rows(C, XN, RSSK(3 * DEPTH), xo, GIN(a, 33));
    PH_END
}
constexpr int N_PHASES = 1 + DEPTH * 10 + 1;

extern "C" void kernel_launch(void* const* d_in, const int* in_sizes, int n_in, void* d_out, int out_size, void* d_ws, size_t ws_size, hipStream_t stream) {
    static int grid = 0;
    if (grid == 0) {
        if (n_in != 34 || in_sizes[0] != MTOK * DM || out_size != MTOK * DM || ws_size < WS_END) {
            fprintf(stderr, "kernel_launch: shape/workspace mismatch: n_in %d in0 %d out %d ws %zu (need %zu)\n", n_in, n_in > 0 ? in_sizes[0] : -1, out_size, ws_size, (size_t)WS_END); grid = -1; return; }
        int dev = 0, cus = 0, per = 0;
        (void)hipGetDevice(&dev);
        (void)hipDeviceGetAttribute(&cus, hipDeviceAttributeMultiprocessorCount, dev);
        if (hipFuncSetAttribute((const void*)mega, hipFuncAttributeMaxDynamicSharedMemorySize, LDS_BYTES) != hipSuccess) { fprintf(stderr, "kernel_launch: hipFuncSetAttribute failed\n"); grid = -1; return; }
        (void)hipOccupancyMaxActiveBlocksPerMultiprocessor(&per, (const void*)mega, 512, LDS_BYTES);
        if (per < 1) per = 1;
        grid = cus * per;
        fprintf(stderr, "kernel_launch: grid %d (cus %d x %d), ws %zu\n", grid, cus, per, ws_size);
    }
    if (grid < 0) return;
    if (hipMemsetAsync((char*)d_ws + 16384, 0, XCD_BAR_WORDS * 4, stream) != hipSuccess) { fprintf(stderr, "kernel_launch: memset of barrier words failed\n"); return; }
    Args a{};
    for (int i = 0; i < 34; ++i) a.in[i] = d_in[i];
    a.out = (float*)d_out; a.ws = (unsigned char*)d_ws; a.ph_lo = 0; a.ph_hi = N_PHASES;
    void* args[] = {&a};
    hipError_t e = hipLaunchCooperativeKernel((const void*)mega, dim3(grid), dim3(512), args, LDS_BYTES, stream);
    if (e != hipSuccess) fprintf(stderr, "kernel_launch: cooperative launch failed: %s (grid %d)\n", hipGetErrorString(e), grid);
}
```
